# Optimizing an MI355X kernel written in HIP

```python
import math
import jax, jax.numpy as jnp
from jax import lax
import numpy as np

D_MODEL = 2048
BATCH = 32
SEQ = 256
DEPTH = 1
DEC_BATCH = 2
DEC_SEQ = 4096
PAST_LEN = 256

GRID_W = 64
D_HYENA = 1024
HYENA_ORDER = 2
FILTER_EMB = 33
FILTER_HIDDEN = 64
DECAY_FAST = 0.3
DECAY_SLOW = 1.5
DECAY_TARGET = 1e-2
MAX_DECAY = math.log(DECAY_TARGET) / DECAY_FAST
MIN_DECAY = math.log(DECAY_TARGET) / DECAY_SLOW
D_SSM = 1024
SSM_GROUP = 16
N_GROUPS = D_SSM // SSM_GROUP
SSM_STATE = 64
DT_MIN = 1e-3
DT_MAX = 1e-1
LAMBDA_RE_MAX = -1e-4
D_FF = 5632
N_IN = 3 * D_HYENA + D_SSM + 2 * D_MODEL
EPS = 1e-6

kernel_name = 'hyena_s5_gated_hybrid_dit_step'

F32 = jnp.float32


def _rmsnorm(x, g):
    xf = x.astype(F32)
    y = xf * lax.rsqrt(jnp.mean(xf * xf, axis=-1, keepdims=True) + EPS) * g.astype(F32)
    return y.astype(x.dtype)


def _short_conv(x, w, b):
    xp = jnp.pad(x, ((0, 0), (1, 1), (0, 0)))
    return xp[:, :-2] * w[0] + xp[:, 1:-1] * w[1] + xp[:, 2:] * w[2] + b


def _dwconv3x3(x, w, b, rows, cols):
    bsz, n, ch = x.shape
    xg = jnp.pad(x.reshape(bsz, rows, cols, ch), ((0, 0), (1, 1), (1, 1), (0, 0)))
    y = b
    for i in range(3):
        for j in range(3):
            y = y + xg[:, i:i + rows, j:j + cols] * w[i, j]
    return y.reshape(bsz, n, ch)


def _hyena_filters(L, w1, b1, w2, b2, w3, b3, w4, freq):
    pos = jnp.arange(L, dtype=F32)
    t = jnp.linspace(0.0, 1.0, L, dtype=F32)
    bands = (FILTER_EMB - 1) // 2
    fr = jnp.linspace(1e-4, bands - 1, bands, dtype=F32)
    ang = (2.0 * math.pi / L) * pos[:, None] * fr[None, :]
    z = jnp.concatenate([t[:, None], jnp.cos(ang), -jnp.sin(ang)], axis=-1)
    fq = freq.astype(F32)
    h = jnp.sin(fq * (z @ w1.astype(F32) + b1.astype(F32)))
    h = jnp.sin(fq * (h @ w2.astype(F32) + b2.astype(F32)))
    h = jnp.sin(fq * (h @ w3.astype(F32) + b3.astype(F32)))
    h = (h @ w4.astype(F32)).reshape(L, HYENA_ORDER, 2, D_HYENA)
    deltas = jnp.abs(jnp.linspace(MIN_DECAY, MAX_DECAY, D_HYENA, dtype=F32))
    decay = jnp.exp(-t[:, None] * deltas[None, :])
    h = h * decay[:, None, None, :]
    fwd, bwd = h[:, :, 0], h[:, :, 1]
    k = jnp.concatenate([fwd, jnp.zeros((1, HYENA_ORDER, D_HYENA), F32), bwd[:0:-1]], axis=0)
    k = k / jnp.sum(jnp.abs(k), axis=0, keepdims=True)
    return jnp.fft.rfft(k, axis=0)


def _hyena_mixer(u, p):
    L = u.shape[1]
    uc = _short_conv(u, p['hy_short_w'], p['hy_short_b']).astype(F32)
    x1, x2, v = jnp.split(uc, 3, axis=-1)
    k_f = _hyena_filters(L, p['hy_f_w1'], p['hy_f_b1'], p['hy_f_w2'], p['hy_f_b2'],
                         p['hy_f_w3'], p['hy_f_b3'], p['hy_f_w4'], p['hy_f_freq'])
    bias = p['hy_bias'].astype(F32)
    z = v
    for o, gate in enumerate((x1, x2)):
        z_f = jnp.fft.rfft(z, n=2 * L, axis=1)
        conv = jnp.fft.irfft(z_f * k_f[None, :, o], n=2 * L, axis=1)[:, :L]
        z = gate * (conv + bias[o] * z)
    return z.astype(u.dtype)


def _scan_combine(left, right):
    a1, b1 = left
    a2, b2 = right
    return a1 * a2, a2 * b1 + b2


def _s5_mixer(u, s0, p):
    bsz, L, _ = u.shape
    uf = u.astype(F32)
    uc = uf.reshape(bsz, L, N_GROUPS, SSM_GROUP).astype(jnp.complex64)
    lam = lax.complex(jnp.minimum(p['ssm_lambda_re'].astype(F32), LAMBDA_RE_MAX),
                      p['ssm_lambda_im'].astype(F32))
    dt = jnp.exp(p['ssm_log_dt'].astype(F32))[..., None]
    lam_bar = jnp.exp(lam * dt)
    b_c = lax.complex(p['ssm_b_re'].astype(F32), p['ssm_b_im'].astype(F32))
    b_bar = ((lam_bar - 1.0) / lam)[..., None] * b_c
    c_c = lax.complex(p['ssm_c_re'].astype(F32), p['ssm_c_im'].astype(F32))
    y = uf * p['ssm_d'].astype(F32)
    finals = []
    for direction in range(2):
        reverse = direction == 1
        bu = jnp.einsum('blgc,gpc->blgp', uc, b_bar[direction])
        if s0 is not None:
            edge = -1 if reverse else 0
            bu = bu.at[:, edge].add(lam_bar[direction] * s0[:, direction])
        a = jnp.broadcast_to(lam_bar[direction], bu.shape)
        _, s = lax.associative_scan(_scan_combine, (a, bu), reverse=reverse, axis=1)
        y = y + jnp.real(jnp.einsum('blgp,gcp->blgc', s, c_c[direction])).reshape(bsz, L, D_SSM)
        finals.append(s[:, 0] if reverse else s[:, -1])
    g = jax.nn.gelu(y)
    out = g * jax.nn.sigmoid(g @ p['ssm_glu_w'].astype(F32) + p['ssm_glu_b'].astype(F32))
    return out.astype(u.dtype), jnp.stack(finals, axis=1)


def _layer(x, cond, s0, rows, cols, p):
    mod = jax.nn.silu(cond) @ p['ada_w'] + p['ada_b']
    sh1, sc1, g1, sh2, sc2, g2 = jnp.split(mod[:, None, :], 6, axis=-1)
    h = _rmsnorm(x, p['norm1_g']) * (1.0 + sc1) + sh1
    proj = h @ p['w_in'] + p['b_in']
    s_a = 3 * D_HYENA
    s_b = s_a + D_SSM
    s_c = s_b + D_MODEL
    hy_in, ssm_in, gate_h, gate_s = jnp.split(proj, [s_a, s_b, s_c], axis=-1)
    y_h = _hyena_mixer(hy_in, p)
    y_s, st = _s5_mixer(ssm_in, s0, p)
    merged = (jax.nn.sigmoid(gate_h) * (y_h @ p['w_branch_h'])
              + jax.nn.sigmoid(gate_s) * (y_s @ p['w_branch_s']))
    x = x + g1 * (merged @ p['w_out'])
    h = _rmsnorm(x, p['norm2_g']) * (1.0 + sc2) + sh2
    up = _dwconv3x3(h @ p['ffn_up'], p['ffn_conv_w'], p['ffn_conv_b'], rows, cols)
    a, b = jnp.split(up, 2, axis=-1)
    x = x + g2 * ((jax.nn.gelu(a) * b) @ p['ffn_down'])
    return x, st


def setup_inputs(seed: int = 0) -> dict:
    key = jax.random.key(seed)
    keys = iter(jax.random.split(key, 64))

    def nrm(shape, scale):
        return jax.random.normal(next(keys), shape, F32) * scale

    ssm_shape = (DEPTH, 2, N_GROUPS, SSM_STATE)
    lam_im = jnp.broadcast_to(math.pi * jnp.arange(SSM_STATE, dtype=F32), ssm_shape)
    return {
        'x_prompt': nrm((BATCH, SEQ, D_MODEL), 1.0),
        'x_sample': nrm((DEC_BATCH, DEC_SEQ, D_MODEL), 1.0),
        'state_ssm_re': nrm((DEC_BATCH, DEPTH, 2, N_GROUPS, SSM_STATE), 0.5),
        'state_ssm_im': nrm((DEC_BATCH, DEPTH, 2, N_GROUPS, SSM_STATE), 0.5),
        'c': nrm((DEC_BATCH, D_MODEL), 1.0),
        'c_ctx': nrm((D_MODEL,), 1.0),
        'ada_w': nrm((DEPTH, D_MODEL, 6 * D_MODEL), 0.5 * D_MODEL ** -0.5),
        'ada_b': nrm((DEPTH, 6 * D_MODEL), 0.02),
        'norm1_g': 1.0 + nrm((DEPTH, D_MODEL), 0.02),
        'norm2_g': 1.0 + nrm((DEPTH, D_MODEL), 0.02),
        'final_g': 1.0 + nrm((D_MODEL,), 0.02),
        'w_in': nrm((DEPTH, D_MODEL, N_IN), D_MODEL ** -0.5),
        'b_in': nrm((DEPTH, N_IN), 0.02),
        'hy_short_w': nrm((DEPTH, 3, 3 * D_HYENA), 3 ** -0.5),
        'hy_short_b': nrm((DEPTH, 3 * D_HYENA), 0.02),
        'hy_f_w1': nrm((DEPTH, FILTER_EMB, FILTER_HIDDEN), FILTER_EMB ** -0.5),
        'hy_f_b1': nrm((DEPTH, FILTER_HIDDEN), 0.1),
        'hy_f_w2': nrm((DEPTH, FILTER_HIDDEN, FILTER_HIDDEN), FILTER_HIDDEN ** -0.5),
        'hy_f_b2': nrm((DEPTH, FILTER_HIDDEN), 0.1),
        'hy_f_w3': nrm((DEPTH, FILTER_HIDDEN, FILTER_HIDDEN), FILTER_HIDDEN ** -0.5),
        'hy_f_b3': nrm((DEPTH, FILTER_HIDDEN), 0.1),
        'hy_f_w4': nrm((DEPTH, FILTER_HIDDEN, HYENA_ORDER * 2 * D_HYENA), FILTER_HIDDEN ** -0.5),
        'hy_f_freq': 1.0 + nrm((DEPTH, FILTER_HIDDEN), 0.01),
        'hy_bias': nrm((DEPTH, HYENA_ORDER, D_HYENA), 1.0),
        'w_branch_h': nrm((DEPTH, D_HYENA, D_MODEL), D_HYENA ** -0.5),
        'ssm_lambda_re': -0.5 + nrm(ssm_shape, 0.01),
        'ssm_lambda_im': lam_im + nrm(ssm_shape, 0.01),
        'ssm_log_dt': jax.random.uniform(next(keys), (DEPTH, 2, N_GROUPS), F32,
                                         math.log(DT_MIN), math.log(DT_MAX)),
        'ssm_b_re': nrm((DEPTH, 2, N_GROUPS, SSM_STATE, SSM_GROUP), (2 * SSM_GROUP) ** -0.5),
        'ssm_b_im': nrm((DEPTH, 2, N_GROUPS, SSM_STATE, SSM_GROUP), (2 * SSM_GROUP) ** -0.5),
        'ssm_c_re': nrm((DEPTH, 2, N_GROUPS, SSM_GROUP, SSM_STATE), (2 * SSM_STATE) ** -0.5),
        'ssm_c_im': nrm((DEPTH, 2, N_GROUPS, SSM_GROUP, SSM_STATE), (2 * SSM_STATE) ** -0.5),
        'ssm_d': nrm((DEPTH, D_SSM), 1.0),
        'ssm_glu_w': nrm((DEPTH, D_SSM, D_SSM), D_SSM ** -0.5),
        'ssm_glu_b': nrm((DEPTH, D_SSM), 0.02),
        'w_branch_s': nrm((DEPTH, D_SSM, D_MODEL), D_SSM ** -0.5),
        'w_out': nrm((DEPTH, D_MODEL, D_MODEL), D_MODEL ** -0.5),
        'ffn_up': nrm((DEPTH, D_MODEL, 2 * D_FF), D_MODEL ** -0.5),
        'ffn_conv_w': nrm((DEPTH, 3, 3, 2 * D_FF), 1.0 / 3.0),
        'ffn_conv_b': nrm((DEPTH, 2 * D_FF), 0.02),
        'ffn_down': nrm((DEPTH, D_FF, D_MODEL), D_FF ** -0.5),
    }


def reference(x_prompt, x_sample, state_ssm_re, state_ssm_im, c, c_ctx,
              ada_w, ada_b, norm1_g, norm2_g, final_g, w_in, b_in,
              hy_short_w, hy_short_b, hy_f_w1, hy_f_b1, hy_f_w2, hy_f_b2, hy_f_w3, hy_f_b3,
              hy_f_w4, hy_f_freq, hy_bias, w_branch_h,
              ssm_lambda_re, ssm_lambda_im, ssm_log_dt, ssm_b_re, ssm_b_im, ssm_c_re, ssm_c_im,
              ssm_d, ssm_glu_w, ssm_glu_b, w_branch_s, w_out,
              ffn_up, ffn_conv_w, ffn_conv_b, ffn_down):
    ctx_len = x_prompt.shape[1]
    rows = x_sample.shape[1] // GRID_W
    xp, xs = x_prompt, x_sample
    new_re, new_im = [], []
    for l in range(DEPTH):
        p = {
            'ada_w': ada_w[l], 'ada_b': ada_b[l], 'norm1_g': norm1_g[l], 'norm2_g': norm2_g[l],
            'w_in': w_in[l], 'b_in': b_in[l],
            'hy_short_w': hy_short_w[l], 'hy_short_b': hy_short_b[l],
            'hy_f_w1': hy_f_w1[l], 'hy_f_b1': hy_f_b1[l], 'hy_f_w2': hy_f_w2[l], 'hy_f_b2': hy_f_b2[l],
            'hy_f_w3': hy_f_w3[l], 'hy_f_b3': hy_f_b3[l], 'hy_f_w4': hy_f_w4[l],
            'hy_f_freq': hy_f_freq[l], 'hy_bias': hy_bias[l], 'w_branch_h': w_branch_h[l],
            'ssm_lambda_re': ssm_lambda_re[l], 'ssm_lambda_im': ssm_lambda_im[l],
            'ssm_log_dt': ssm_log_dt[l], 'ssm_b_re': ssm_b_re[l], 'ssm_b_im': ssm_b_im[l],
            'ssm_c_re': ssm_c_re[l], 'ssm_c_im': ssm_c_im[l], 'ssm_d': ssm_d[l],
            'ssm_glu_w': ssm_glu_w[l], 'ssm_glu_b': ssm_glu_b[l], 'w_branch_s': w_branch_s[l],
            'w_out': w_out[l], 'ffn_up': ffn_up[l], 'ffn_conv_w': ffn_conv_w[l],
            'ffn_conv_b': ffn_conv_b[l], 'ffn_down': ffn_down[l],
        }
        xp, st = _layer(xp, c_ctx[None, :], None, 1, ctx_len, p)
        new_re.append(jnp.real(st))
        new_im.append(jnp.imag(st))
        s0 = lax.complex(state_ssm_re[:, l].astype(F32), state_ssm_im[:, l].astype(F32))
        xs, _ = _layer(xs, c, s0, rows, GRID_W, p)
    y_prompt = _rmsnorm(xp, final_g)
    y_sample = _rmsnorm(xs, final_g)
    new_state_ssm_re = jnp.stack(new_re, axis=1)
    new_state_ssm_im = jnp.stack(new_im, axis=1)
    return (y_prompt, y_sample, new_state_ssm_re, new_state_ssm_im)
```

```cpp
#include <hip/hip_runtime.h>
#include <hip/hip_cooperative_groups.h>
#include <cstdio>
#include <cstdint>
namespace cg = cooperative_groups;
namespace pg8 {
#define PG8_LAS __attribute__((address_space(3)))
typedef unsigned short bf16_t;
typedef short bf16x8 __attribute__((ext_vector_type(8)));
typedef float f32x4 __attribute__((ext_vector_type(4)));
typedef unsigned u32x4 __attribute__((ext_vector_type(4)));
constexpr int BM = 256, BK = 64, HALF = 128, HTB = HALF * BK * 2  , STAGE_BYTES = 8 * HTB, NXCD = 8, WGM = 8;

__host__ __device__ __forceinline__ int lds_byte(int r, int c) { const int st = (r >> 4) * 2 + (c >> 5), rr = r & 15, cc = c & 31, ob = rr * 64 + cc * 2; return st * 1024 + (ob ^ (((ob >> 9) & 1) << 5)); }
__host__ __device__ __forceinline__ void stage_rc(int b, int& R, int& C) { const int st = b / 1024, sb = b % 1024, swz = sb ^ (((sb >> 9) & 1) << 5); R = (st >> 1) * 16 + swz / 64; C = (st & 1) * 32 + (swz % 64) / 2; }
__host__ __device__ __forceinline__ int perm32(int rho) { const int n = rho >> 4, i = rho & 15; return 8 * (i >> 2) + 4 * n + (i & 3); }

struct Unit { int pm, pn; };
struct Gemm { const bf16_t* A; const bf16_t* Bt; int M, N, K; };

struct StaticOrder {
    int nM, nN, nwg, G, c;
    __host__ __device__ void init(int M, int N, int G_, int c_) { nM = M / BM; nN = N / BM; nwg = nM * nN; G = G_; c = c_; }
    __host__ __device__ bool next(int i, Unit& u) const {
        const long L = (long)i * G + c; if (L >= nwg) return false;
        int wgid = (int)L; { const int q = nwg / NXCD, r = nwg % NXCD, xcd = wgid % NXCD, off = wgid / NXCD; wgid = (xcd < r ? xcd * (q + 1) : r * (q + 1) + (xcd - r) * q) + off; }
        const int nig = WGM * nN, gid = wgid / nig, fm = gid * WGM, gsz = (nM - fm) < WGM ? (nM - fm) : WGM;
        u.pm = fm + ((wgid % nig) % gsz); u.pn = (wgid % nig) / gsz; return true;
    }
    __device__ __forceinline__ void a_ready(const Unit&) const {}
    __device__ __forceinline__ void done(const Unit&) const {}
};

typedef float f32x2c __attribute__((ext_vector_type(2))); typedef __bf16 bf16x2c __attribute__((ext_vector_type(2)));
__device__ __forceinline__ unsigned cvt_pk_bf16(float lo, float hi) { const f32x2c v = {lo, hi}; return __builtin_bit_cast(unsigned, __builtin_convertvector(v, bf16x2c)); }
typedef float f32x2 __attribute__((ext_vector_type(2)));
template <class Epi, class Sched, bool ALIGN_EPI = false, bool SP2 = false>
__device__ __forceinline__ void gemm_phase(PG8_LAS unsigned char* lds, const Gemm g, const Sched& S, const Epi& E) {
    const int tid = threadIdx.x, wid = __builtin_amdgcn_readfirstlane(tid >> 6), lane = tid & 63, wr = wid >> 2, wc = wid & 3, fr = lane & 15, fq = lane >> 4;
    const int K = g.K, nt = K / BK;
    unsigned voffA[2], voffB[2];
#pragma unroll
    for (int i = 0; i < 2; ++i) { int R, C; stage_rc(tid * 16 + i * 8192, R, C); const int Rb = Epi::PERM ? ((R & ~31) + perm32(R & 31)) : R;
        voffA[i] = (unsigned)(R * K + C) * 2u; voffB[i] = (unsigned)(Rb * K + C) * 2u; }
    const size_t kstep = (size_t)(BK * 2);
    const size_t hstep = (size_t)HALF * K * 2;
    const size_t tstep = 2 * hstep;
    const unsigned ldsw = (unsigned)wid * 1024u;
    const int aoff = lds_byte(wr * 64 + fr, fq * 8), boff = lds_byte(wc * 32 + fr, fq * 8);
#define PG8_SA(b, h) (((b) * 2 + (h)) * HTB)
#define PG8_SB(b, h) ((4 + (b) * 2 + (h)) * HTB)
#define PG8_STAGE(bufoff, gbase, voff) do { _Pragma("unroll") for (int _i = 0; _i < 2; ++_i) \
        __builtin_amdgcn_global_load_lds((const unsigned*)((const char*)(gbase) + (voff)[_i]), (PG8_LAS unsigned*)(lds + (bufoff) + ldsw + _i * 8192), 16, 0, 0); } while (0)
#define PG8_LDA(dst, b, h) do { _Pragma("unroll") for (int m = 0; m < 4; ++m) _Pragma("unroll") for (int k = 0; k < 2; ++k) dst[m][k] = *(const PG8_LAS bf16x8*)(lds + PG8_SA(b, h) + aoff + m * 2048 + k * 1024); } while (0)
#define PG8_LDB(dst, b, h) do { _Pragma("unroll") for (int n = 0; n < 2; ++n) _Pragma("unroll") for (int k = 0; k < 2; ++k) dst[n][k] = *(const PG8_LAS bf16x8*)(lds + PG8_SB(b, h) + boff + n * 2048 + k * 1024); } while (0)
#define PG8_MMA(ai, bj, At, Bt) do { __builtin_amdgcn_s_setprio(1); _Pragma("unroll") for (int m = 0; m < 4; ++m) _Pragma("unroll") for (int n = 0; n < 2; ++n) _Pragma("unroll") for (int k = 0; k < 2; ++k) \
        acc[ai][bj][m][n] = __builtin_amdgcn_mfma_f32_16x16x32_bf16(Bt[n][k], At[m][k], acc[ai][bj][m][n], 0, 0, 0); __builtin_amdgcn_s_setprio(0); } while (0)
#define PG8_WAIT_V(n) asm volatile("s_waitcnt vmcnt(" #n ")" ::: "memory")
#define PG8_WAIT_L(n) asm volatile("s_waitcnt lgkmcnt(" #n ")" ::: "memory")
#define PG8_BAR __builtin_amdgcn_s_barrier()
#define PG8_SCHED __builtin_amdgcn_sched_barrier(0)
    Unit cur, nxt; int ui = 0;
    if (!S.next(0, cur)) return;
    f32x4 acc[2][2][4][2];
#pragma unroll
    for (int a = 0; a < 2; ++a)
#pragma unroll
        for (int b = 0; b < 2; ++b)
#pragma unroll
            for (int m = 0; m < 4; ++m)
#pragma unroll
                for (int n = 0; n < 2; ++n) acc[a][b][m][n] = (f32x4){0.f, 0.f, 0.f, 0.f};
    bf16x8 At[4][2], B0[2][2], B1[2][2];
    const char* cA = (const char*)g.A + (size_t)cur.pm * tstep; const char* cB = (const char*)g.Bt + (size_t)cur.pn * tstep;
    S.a_ready(cur);
    if constexpr (SP2) {
        PG8_STAGE(PG8_SB(0, 0), cB, voffB); PG8_STAGE(PG8_SB(0, 1), cB + hstep, voffB); PG8_STAGE(PG8_SA(0, 0), cA, voffA); PG8_STAGE(PG8_SA(0, 1), cA + hstep, voffA);
        if (wr == 1) PG8_BAR;
        PG8_WAIT_V(2); PG8_BAR;
        PG8_STAGE(PG8_SB(1, 0), cB + kstep, voffB); PG8_STAGE(PG8_SA(1, 0), cA + kstep, voffA); PG8_STAGE(PG8_SB(1, 1), cB + hstep + kstep, voffB);
        PG8_WAIT_V(6); PG8_BAR;
    } else {
        PG8_STAGE(PG8_SB(0, 0), cB, voffB); PG8_STAGE(PG8_SA(0, 0), cA, voffA); PG8_STAGE(PG8_SB(0, 1), cB + hstep, voffB); PG8_STAGE(PG8_SA(0, 1), cA + hstep, voffA);
        if (wr == 1) PG8_BAR;
        PG8_WAIT_V(4); PG8_BAR;
        PG8_STAGE(PG8_SB(1, 0), cB + kstep, voffB); PG8_STAGE(PG8_SA(1, 0), cA + kstep, voffA); PG8_STAGE(PG8_SB(1, 1), cB + hstep + kstep, voffB);
        PG8_WAIT_V(6); PG8_BAR;
    }
    for (;;) {
        const bool has_next = S.next(ui + 1, nxt);
        const char* nA = has_next ? (const char*)g.A + (size_t)nxt.pm * tstep : cA; const char* nB = has_next ? (const char*)g.Bt + (size_t)nxt.pn * tstep : cB;
        for (int t = 0; t < nt; t += 2) {
            const bool last = (t == nt - 2);
            const char* a1 = cA + (size_t)(t + 1) * kstep;
            const char* a2 = last ? nA : cA + (size_t)(t + 2) * kstep; const char* b2 = last ? nB : cB + (size_t)(t + 2) * kstep;
            const char* a3 = a2 + kstep; const char* b3 = b2 + kstep;
            if (last && has_next) S.a_ready(nxt);
            if constexpr (SP2) {
            PG8_LDB(B0, 0, 0); PG8_LDB(B1, 0, 1); PG8_SCHED; PG8_LDA(At, 0, 0); PG8_STAGE(PG8_SA(1, 1), a1 + hstep, voffA);
            PG8_WAIT_V(8); PG8_WAIT_L(0); PG8_BAR; PG8_MMA(0, 0, At, B0); PG8_MMA(0, 1, At, B1); PG8_BAR; PG8_SCHED;
            PG8_LDA(At, 0, 1); PG8_STAGE(PG8_SB(0, 0), b2, voffB); PG8_STAGE(PG8_SB(0, 1), b2 + hstep, voffB); PG8_STAGE(PG8_SA(0, 0), a2, voffA);
            PG8_WAIT_V(8); PG8_WAIT_L(0); PG8_BAR; PG8_MMA(1, 0, At, B0); PG8_MMA(1, 1, At, B1); PG8_BAR; PG8_SCHED;
            PG8_LDB(B0, 1, 0); PG8_LDB(B1, 1, 1); PG8_SCHED; PG8_LDA(At, 1, 0); PG8_STAGE(PG8_SA(0, 1), a2 + hstep, voffA);
            PG8_WAIT_V(8); PG8_WAIT_L(0); PG8_BAR; PG8_MMA(0, 0, At, B0); PG8_MMA(0, 1, At, B1); PG8_BAR; PG8_SCHED;
            PG8_LDA(At, 1, 1); PG8_STAGE(PG8_SB(1, 0), b3, voffB); PG8_STAGE(PG8_SB(1, 1), b3 + hstep, voffB); PG8_STAGE(PG8_SA(1, 0), a3, voffA);
            PG8_WAIT_V(8); PG8_WAIT_L(0); PG8_BAR; PG8_MMA(1, 0, At, B0); PG8_MMA(1, 1, At, B1); PG8_BAR; PG8_SCHED;
            } else {
            PG8_LDB(B0, 0, 0); PG8_SCHED; PG8_LDA(At, 0, 0); PG8_STAGE(PG8_SA(1, 1), a1 + hstep, voffA);
            PG8_WAIT_L(8); PG8_BAR; PG8_WAIT_L(0); PG8_MMA(0, 0, At, B0); PG8_BAR; PG8_SCHED;
            PG8_LDB(B1, 0, 1); PG8_STAGE(PG8_SB(0, 0), b2, voffB);
            PG8_BAR; PG8_WAIT_L(0); PG8_MMA(0, 1, At, B1); PG8_BAR;
            PG8_LDA(At, 0, 1); PG8_STAGE(PG8_SA(0, 0), a2, voffA);
            PG8_BAR; PG8_WAIT_L(0); PG8_MMA(1, 0, At, B0); PG8_BAR; PG8_SCHED;
            PG8_STAGE(PG8_SB(0, 1), b2 + hstep, voffB);
            PG8_WAIT_V(6); PG8_BAR; PG8_MMA(1, 1, At, B1); PG8_BAR;
            PG8_LDB(B0, 1, 0); PG8_SCHED; PG8_LDA(At, 1, 0); PG8_STAGE(PG8_SA(0, 1), a2 + hstep, voffA);
            PG8_WAIT_L(8); PG8_BAR; PG8_WAIT_L(0); PG8_MMA(0, 0, At, B0); PG8_BAR; PG8_SCHED;
            PG8_LDB(B1, 1, 1); PG8_STAGE(PG8_SB(1, 0), b3, voffB);
            PG8_BAR; PG8_WAIT_L(0); PG8_MMA(0, 1, At, B1); PG8_BAR;
            PG8_LDA(At, 1, 1); PG8_STAGE(PG8_SA(1, 0), a3, voffA);
            PG8_BAR; PG8_WAIT_L(0); PG8_MMA(1, 0, At, B0); PG8_BAR; PG8_SCHED;
            PG8_STAGE(PG8_SB(1, 1), b3 + hstep, voffB);
            PG8_WAIT_V(6); PG8_BAR; PG8_MMA(1, 1, At, B1); PG8_BAR;
            }
        }
        if constexpr (ALIGN_EPI) { if (wr == 0) PG8_BAR; }
        if constexpr (!Epi::AFTER_DRAIN) { E(acc, cur, wr, wc, fr, fq); S.done(cur); }
        if (!has_next) break;
#pragma unroll
        for (int a = 0; a < 2; ++a)
#pragma unroll
            for (int b = 0; b < 2; ++b)
#pragma unroll
                for (int m = 0; m < 4; ++m)
#pragma unroll
                    for (int n = 0; n < 2; ++n) acc[a][b][m][n] = (f32x4){0.f, 0.f, 0.f, 0.f};
        cur = nxt; cA = nA; cB = nB; ++ui;
        if constexpr (ALIGN_EPI) { if (wr == 1) PG8_BAR; }
    }
    PG8_WAIT_V(0);
    if constexpr (!ALIGN_EPI) { if (wr == 0) PG8_BAR; }
    PG8_BAR;
    if constexpr (Epi::AFTER_DRAIN) { E.fused(acc, cur, wr, wc, fr, fq, lds, wid, lane); S.done(cur); }
#undef PG8_SA
#undef PG8_SB
#undef PG8_STAGE
#undef PG8_LDA
#undef PG8_LDB
#undef PG8_MMA
#undef PG8_WAIT_V
#undef PG8_WAIT_L
#undef PG8_BAR
#undef PG8_SCHED
}
}

namespace pg8 {
typedef unsigned u32x4 __attribute__((ext_vector_type(4)));
__device__ __forceinline__ float bflo(unsigned w) { return __uint_as_float(w << 16); }
__device__ __forceinline__ float bfhi(unsigned w) { return __uint_as_float(w & 0xffff0000u); }
__device__ __forceinline__ float sigm(float x) { return 1.0f / (1.0f + __expf(-x)); }
__device__ __forceinline__ u32x4 pack8(const f32x4 a, const f32x4 b) { u32x4 w; w.x = cvt_pk_bf16(a[0], a[1]); w.y = cvt_pk_bf16(a[2], a[3]); w.z = cvt_pk_bf16(b[0], b[1]); w.w = cvt_pk_bf16(b[2], b[3]); return w; }
__device__ __forceinline__ void unpack8(const u32x4 w, f32x4& a, f32x4& b) { a = (f32x4){bflo(w.x), bfhi(w.x), bflo(w.y), bfhi(w.y)}; b = (f32x4){bflo(w.z), bfhi(w.z), bflo(w.w), bfhi(w.w)}; }

struct EpiHyT {
    static constexpr bool PERM = true, AFTER_DRAIN = false;
    bf16_t* O; const float* bias;
    __device__ __forceinline__ void operator()(const f32x4 (&acc)[2][2][4][2], const Unit& u, int wr, int wc, int fr, int fq) const {
        const int row0 = u.pm * BM + wr * 64 + fr, col0 = u.pn * BM + wc * 32 + 8 * fq;
#pragma unroll
        for (int ai = 0; ai < 2; ++ai)
#pragma unroll
            for (int m = 0; m < 4; ++m) { const int row = row0 + ai * HALF + m * 16; const float bv = bias[row]; bf16_t* rowp = O + (size_t)row * 16384 + col0;
#pragma unroll
                for (int bj = 0; bj < 2; ++bj) { const f32x4 v0 = acc[ai][bj][m][0] + bv, v1 = acc[ai][bj][m][1] + bv; *(u32x4*)(rowp + bj * HALF) = pack8(v0, v1); } }
    }
};
struct EpiRest {
    static constexpr bool PERM = true, AFTER_DRAIN = false;
    bf16_t* Ossm; bf16_t* Ogates; const float* bias;
    __device__ __forceinline__ void operator()(const f32x4 (&acc)[2][2][4][2], const Unit& u, int wr, int wc, int fr, int fq) const {
        const int row0 = u.pm * BM + wr * 64 + fr; const int colt = u.pn * BM;
        bf16_t* base; int ldc, cb;
        if (u.pn < 4) { base = Ossm; ldc = 1024; cb = colt; } else { base = Ogates; ldc = 4096; cb = colt - 1024; }
        const int col0 = cb + wc * 32 + 8 * fq, bcol0 = colt + wc * 32 + 8 * fq;
        f32x4 bv[2][2];
#pragma unroll
        for (int bj = 0; bj < 2; ++bj)
#pragma unroll
            for (int n = 0; n < 2; ++n) bv[bj][n] = *(const f32x4*)(bias + bcol0 + bj * HALF + 4 * n);
#pragma unroll
        for (int ai = 0; ai < 2; ++ai)
#pragma unroll
            for (int m = 0; m < 4; ++m) { bf16_t* rowp = base + (size_t)(row0 + ai * HALF + m * 16) * ldc + col0;
#pragma unroll
                for (int bj = 0; bj < 2; ++bj) { const f32x4 v0 = acc[ai][bj][m][0] + bv[bj][0], v1 = acc[ai][bj][m][1] + bv[bj][1];
                    if (u.pn < 4) *(u32x4*)(rowp + bj * HALF) = pack8(v0, v1);
                    else {
                        typedef unsigned u32x2 __attribute__((ext_vector_type(2)));
                        unsigned q[8];
#pragma unroll
                        for (int e = 0; e < 4; ++e) { q[e] = (unsigned)(sigm(v0[e]) * 255.0f + 0.5f); q[4 + e] = (unsigned)(sigm(v1[e]) * 255.0f + 0.5f); }
                        u32x2 w; w.x = q[0] | (q[1] << 8) | (q[2] << 16) | (q[3] << 24); w.y = q[4] | (q[5] << 8) | (q[6] << 16) | (q[7] << 24);
                        *(u32x2*)((unsigned char*)Ogates + (size_t)(row0 + ai * HALF + m * 16) * 4096 + col0 + bj * HALF) = w; } } }
    }
};
template <int MODE> struct EpiBr {
    static constexpr bool PERM = true, AFTER_DRAIN = false;
    bf16_t* O; const unsigned char* G; int goff;
    __device__ __forceinline__ void operator()(const f32x4 (&acc)[2][2][4][2], const Unit& u, int wr, int wc, int fr, int fq) const {
        typedef unsigned u32x2 __attribute__((ext_vector_type(2)));
        const int row0 = u.pm * BM + wr * 64 + fr, col0 = u.pn * BM + wc * 32 + 8 * fq;
#pragma unroll
        for (int ai = 0; ai < 2; ++ai)
#pragma unroll
            for (int m = 0; m < 4; ++m) { const size_t row = (size_t)(row0 + ai * HALF + m * 16);
#pragma unroll
                for (int bj = 0; bj < 2; ++bj) {
                    const u32x2 gw = *(const u32x2*)(G + row * 4096 + goff + col0 + bj * HALF);
                    f32x4 o0, o1;
#pragma unroll
                    for (int e = 0; e < 4; ++e) { o0[e] = (float)((gw.x >> (8 * e)) & 255u) * (1.0f / 255.0f) * acc[ai][bj][m][0][e]; o1[e] = (float)((gw.y >> (8 * e)) & 255u) * (1.0f / 255.0f) * acc[ai][bj][m][1][e]; }
                    bf16_t* op = O + row * 2048 + col0 + bj * HALF;
                    if (MODE == 2) { const u32x4 pw = *(const u32x4*)op; f32x4 p0, p1; unpack8(pw, p0, p1); o0 += p0; o1 += p1; }
                    *(u32x4*)op = pack8(o0, o1); } }
    }
};
struct EpiPlain {
    static constexpr bool PERM = true, AFTER_DRAIN = false;
    bf16_t* O; int ldc;
    __device__ __forceinline__ void operator()(const f32x4 (&acc)[2][2][4][2], const Unit& u, int wr, int wc, int fr, int fq) const {
        const int row0 = u.pm * BM + wr * 64 + fr, col0 = u.pn * BM + wc * 32 + 8 * fq;
#pragma unroll
        for (int ai = 0; ai < 2; ++ai)
#pragma unroll
            for (int m = 0; m < 4; ++m) { bf16_t* rowp = O + (size_t)(row0 + ai * HALF + m * 16) * ldc + col0;
#pragma unroll
                for (int bj = 0; bj < 2; ++bj) *(u32x4*)(rowp + bj * HALF) = pack8(acc[ai][bj][m][0], acc[ai][bj][m][1]); }
    }
};
template <int MODE> struct EpiGate {
    static constexpr bool PERM = true, AFTER_DRAIN = false;
    bf16_t* O; int ldc; const bf16_t* G; int ldg; const float* bias;
    __device__ __forceinline__ void operator()(const f32x4 (&acc)[2][2][4][2], const Unit& u, int wr, int wc, int fr, int fq) const {
        const int row0 = u.pm * BM + wr * 64 + fr, col0 = u.pn * BM + wc * 32 + 8 * fq;
        f32x4 bv[2][2];
#pragma unroll
        for (int bj = 0; bj < 2; ++bj)
#pragma unroll
            for (int n = 0; n < 2; ++n) bv[bj][n] = (MODE == 0) ? *(const f32x4*)(bias + col0 + bj * HALF + 4 * n) : (f32x4){0.f, 0.f, 0.f, 0.f};
#pragma unroll
        for (int ai = 0; ai < 2; ++ai)
#pragma unroll
            for (int m = 0; m < 4; ++m) { const size_t row = (size_t)(row0 + ai * HALF + m * 16);
#pragma unroll
                for (int bj = 0; bj < 2; ++bj) {
                    const u32x4 gw = *(const u32x4*)(G + row * ldg + col0 + bj * HALF); f32x4 g0, g1; unpack8(gw, g0, g1);
                    f32x4 v0 = acc[ai][bj][m][0] + bv[bj][0], v1 = acc[ai][bj][m][1] + bv[bj][1], o0, o1;
                    bf16_t* op = O + row * ldc + col0 + bj * HALF;
                    if (MODE == 0) {
#pragma unroll
                        for (int e = 0; e < 4; ++e) { o0[e] = g0[e] * sigm(v0[e]); o1[e] = g1[e] * sigm(v1[e]); }
                    } else {
#pragma unroll
                        for (int e = 0; e < 4; ++e) { o0[e] = sigm(g0[e]) * v0[e]; o1[e] = sigm(g1[e]) * v1[e]; }
                        if (MODE == 2) { const u32x4 pw = *(const u32x4*)op; f32x4 p0, p1; unpack8(pw, p0, p1); o0 += p0; o1 += p1; }
                    }
                    *(u32x4*)op = pack8(o0, o1); } }
    }
};
struct EpiRes {
    static constexpr bool PERM = false, AFTER_DRAIN = false;
    const float* xp; const float* xs; float* out; const float* gate;
    __device__ __forceinline__ void operator()(const f32x4 (&acc)[2][2][4][2], const Unit& u, int wr, int wc, int fr, int fq) const {
        typedef unsigned u32x2 __attribute__((ext_vector_type(2)));
        const int col0 = u.pn * BM + wc * 32 + 4 * fq;
#pragma unroll
        for (int ai = 0; ai < 2; ++ai)
#pragma unroll
            for (int m = 0; m < 4; ++m) { const int r = u.pm * BM + ai * HALF + wr * 64 + m * 16 + fr; const size_t off = (size_t)r * 2048 + col0;
                const int type = r < 8192 ? 0 : 1 + ((r - 8192) >> 12);
                const float* bp = r < 8192 ? xp + off : xs + (off - (size_t)8192 * 2048);
                bf16_t* ob = (bf16_t*)out + (size_t)r * 4096 + col0;
                const float* gp = gate + type * 12288 + col0;
#pragma unroll
                for (int bj = 0; bj < 2; ++bj)
#pragma unroll
                    for (int n = 0; n < 2; ++n) { f32x4 bs;
                        if (xp) bs = *(const f32x4*)(bp + bj * HALF + n * 16);
                        else { const u32x2 w = *(const u32x2*)(ob + bj * HALF + n * 16); bs = (f32x4){bflo(w.x), bfhi(w.x), bflo(w.y), bfhi(w.y)}; }
                        const f32x4 gv = *(const f32x4*)(gp + bj * HALF + n * 16);
                        const f32x4 o = bs + gv * acc[ai][bj][m][n];
                        u32x2 ow; ow.x = cvt_pk_bf16(o[0], o[1]); ow.y = cvt_pk_bf16(o[2], o[3]);
                        *(u32x2*)(ob + bj * HALF + n * 16) = ow; } }
    }
};
}

#define LAS __attribute__((address_space(3)))
typedef unsigned short bf16;
typedef unsigned v4u __attribute__((ext_vector_type(4)));
typedef unsigned v2u __attribute__((ext_vector_type(2)));
typedef float f32x4 __attribute__((ext_vector_type(4)));
typedef float f32x16 __attribute__((ext_vector_type(16)));
typedef short bf16x8 __attribute__((ext_vector_type(8)));
typedef short bf16x4 __attribute__((ext_vector_type(4)));

constexpr int NWAVES = 8, NTHR = 512, LDS_BYTES = 147456;
constexpr size_t MiB = 1u << 20;
constexpr size_t WS_MOD = 0, ZERO_BYTES = 256 * 1024;
constexpr size_t WS_BAR = 192 * 1024;
constexpr size_t WS_H3 = 1 * MiB, WS_PART = 3 * MiB, WS_SLOC = 5 * MiB;
constexpr size_t WS_WIN = 16 * MiB, WS_WGLU = 48 * MiB, WS_WBH = 50 * MiB, WS_WBS = 54 * MiB, WS_WOUT = 58 * MiB;
constexpr size_t WS_FILT1 = 66 * MiB, WS_FILT0 = 98 * MiB;
constexpr size_t WS_HYT = 100 * MiB, WS_SSM = 196 * MiB, WS_GATES = 228 * MiB, WS_G = 356 * MiB, WS_A = 392 * MiB, WS_END = 456 * MiB;
constexpr size_t WS_YHT = 16 * MiB;
constexpr size_t WS_YH = 66 * MiB, WS_YS = WS_SSM, WS_MERGED = WS_HYT;
constexpr size_t WS_WUP = 16 * MiB, WS_WD0 = 60 * MiB, WS_WD1 = 70 * MiB, WS_UP = 82 * MiB, WS_ACT = 274 * MiB;
constexpr int CA0 = 2560, CA1 = 3072;

struct Args { const float* in[41]; float* out; unsigned char* ws; int ph_lo, ph_hi; };
#define KA const __attribute__((address_space(4))) Args&
__device__ __forceinline__ const __attribute__((address_space(4))) Args* kargs() { auto p = __builtin_amdgcn_kernarg_segment_ptr(); asm volatile("" : "+s"(p)); return (const __attribute__((address_space(4))) Args*)p; }

__device__ __forceinline__ unsigned pkbf(float lo, float hi) { return pg8::cvt_pk_bf16(lo, hi); }
__device__ __forceinline__ float bf2f(bf16 b) { return __uint_as_float((unsigned)b << 16); }
__device__ __forceinline__ bf16 f2bf(float f) { return (bf16)(pkbf(f, 0.f) & 0xffffu); }
__device__ __forceinline__ float rdlane(float v, int l);
__device__ __forceinline__ float wave_sum(float v) {
    v += __int_as_float(__builtin_amdgcn_update_dpp(0, __float_as_int(v), 0xB1, 0xf, 0xf, false));
    v += __int_as_float(__builtin_amdgcn_update_dpp(0, __float_as_int(v), 0x4E, 0xf, 0xf, false));
    v += __int_as_float(__builtin_amdgcn_update_dpp(0, __float_as_int(v), 0x141, 0xf, 0xf, false));
    v += __int_as_float(__builtin_amdgcn_update_dpp(0, __float_as_int(v), 0x140, 0xf, 0xf, false));
    const float t0 = __int_as_float(__builtin_amdgcn_readlane(__float_as_int(v), 0)), t1 = __int_as_float(__builtin_amdgcn_readlane(__float_as_int(v), 16));
    const float t2 = __int_as_float(__builtin_amdgcn_readlane(__float_as_int(v), 32)), t3 = __int_as_float(__builtin_amdgcn_readlane(__float_as_int(v), 48));
    return (t0 + t1) + (t2 + t3);
}
__device__ __forceinline__ float rdlane(float v, int l) { return __int_as_float(__builtin_amdgcn_readlane(__float_as_int(v), l)); }
__device__ __forceinline__ float silu_f(float x) { return x / (1.0f + __expf(-x)); }
__device__ __forceinline__ float gelu_tanh(float x) { const float u = 0.7978845608028654f * (x + 0.044715f * x * x * x); const float t = 1.0f - 2.0f / (__expf(2.0f * u) + 1.0f); return 0.5f * x * (1.0f + t); }
#define LDS_FENCE() asm volatile("s_waitcnt lgkmcnt(0)" ::: "memory")

__device__ __forceinline__ void transpose_item(const float* W, int N, bf16* WT, int ldk, int dst_row0, int dst_k0, int k0, int n0, LAS float* scr, int lane) {
    const int rs = lane >> 4, c4 = lane & 15;
    f32x4 v[16];
#pragma unroll
    for (int i = 0; i < 16; ++i) v[i] = *(const f32x4*)(W + (size_t)(k0 + 4 * i + rs) * N + n0 + 4 * c4);
#pragma unroll
    for (int i = 0; i < 16; ++i) { LAS float* d = scr + (4 * i + rs) * 65 + 4 * c4; d[0] = v[i].x; d[1] = v[i].y; d[2] = v[i].z; d[3] = v[i].w; }
    LDS_FENCE();
    const int c = lane & 7, ns = lane >> 3;
#pragma unroll
    for (int j = 0; j < 8; ++j) { const int n = ns + 8 * j; const LAS float* s = scr + (8 * c) * 65 + n;
        v4u o; o.x = pkbf(s[0 * 65], s[1 * 65]); o.y = pkbf(s[2 * 65], s[3 * 65]); o.z = pkbf(s[4 * 65], s[5 * 65]); o.w = pkbf(s[6 * 65], s[7 * 65]);
        *(v4u*)(WT + (size_t)(dst_row0 + n) * ldk + dst_k0 + 8 * c) = o; }
    LDS_FENCE();
}

template <int MODE> __device__ __forceinline__ void norm_row(const float* xrow, const float* g, const float* sc, const float* sh, void* orow, int lane) {
    const f32x4* xr = (const f32x4*)xrow + lane;
    f32x4 v[8]; float s = 0.f;
#pragma unroll
    for (int j = 0; j < 8; ++j) { v[j] = xr[64 * j]; s += (v[j].x * v[j].x + v[j].y * v[j].y) + (v[j].z * v[j].z + v[j].w * v[j].w); }
    const float rstd = 1.0f / sqrtf(wave_sum(s) * (1.0f / 2048.0f) + 1e-6f);
#pragma unroll
    for (int j = 0; j < 8; ++j) { const int col = 4 * lane + 256 * j; const f32x4 gv = *(const f32x4*)(g + col); f32x4 y = v[j] * rstd * gv;
        if (MODE == 0) { const f32x4 scv = *(const f32x4*)(sc + col), shv = *(const f32x4*)(sh + col); y = y * (scv + 1.0f) + shv;
            v2u o; o.x = pkbf(y.x, y.y); o.y = pkbf(y.z, y.w); *(v2u*)((bf16*)orow + col) = o; }
        else *(f32x4*)((float*)orow + col) = y; }
}

template <int MODE, bool XBF> __device__ __forceinline__ void norm_rows(const float* x0, const float* x1  , const float* g, const float* modsc, const float* modsh, void* out, int gw, int NGW, int lane) {
    f32x4 A[8], B[8]; int cur = -1;
    for (int r = gw; r < 16384; r += NGW) {
        const int type = MODE == 0 ? (r < 8192 ? 0 : 1 + ((r - 8192) >> 12)) : 0;
        if (type != cur) { cur = type;
#pragma unroll
            for (int j = 0; j < 8; ++j) { const int col = 4 * lane + 256 * j; const f32x4 gv = *(const f32x4*)(g + col);
                if (MODE == 0) { A[j] = gv * (*(const f32x4*)(modsc + type * 12288 + col) + 1.0f); B[j] = *(const f32x4*)(modsh + type * 12288 + col); } else { A[j] = gv; B[j] = (f32x4){0.f, 0.f, 0.f, 0.f}; } } }
        const float* xrow = (x1 && r >= 8192) ? x1 + (size_t)(r - 8192) * 2048 : x0 + (size_t)r * 2048;
        const f32x4* xr = (const f32x4*)xrow + lane; const v2u* xb = (const v2u*)((const bf16*)x0 + (size_t)r * 4096) + lane;
        f32x4 v[8]; float s = 0.f;
#pragma unroll
        for (int j = 0; j < 8; ++j) { if (XBF) { const v2u w = xb[64 * j]; v[j] = (f32x4){pg8::bflo(w.x), pg8::bfhi(w.x), pg8::bflo(w.y), pg8::bfhi(w.y)}; } else v[j] = xr[64 * j];
            s += (v[j].x * v[j].x + v[j].y * v[j].y) + (v[j].z * v[j].z + v[j].w * v[j].w); }
        const float rstd = 1.0f / sqrtf(wave_sum(s) * (1.0f / 2048.0f) + 1e-6f);
#pragma unroll
        for (int j = 0; j < 8; ++j) { const int col = 4 * lane + 256 * j;
            if (MODE == 0) { const f32x4 y = (v[j] * rstd) * A[j] + B[j]; v2u o; o.x = pkbf(y.x, y.y); o.y = pkbf(y.z, y.w); *(v2u*)((bf16*)out + (size_t)r * 2048 + col) = o; }
            else *(f32x4*)((float*)out + (size_t)r * 2048 + col) = (v[j] * rstd) * A[j]; }
    }
}

__device__ __forceinline__ void mod_block_unit(KA a, LAS unsigned char* lds, int u, int tid) {
    const int lane = tid & 63, wave = __builtin_amdgcn_readfirstlane(tid >> 6);
    LAS float* sv = (LAS float*)lds;
    LAS float* red = (LAS float*)(lds + 24576);
    float* mod = (float*)(a.ws + WS_MOD);
    for (int i = tid; i < 2048; i += NTHR) { sv[i] = silu_f(a.in[5][i]); sv[2048 + i] = silu_f(a.in[4][i]); sv[4096 + i] = silu_f(a.in[4][2048 + i]); }
    __syncthreads();
    const int rsub = lane >> 4, c4 = lane & 15;
    const float* wp = a.in[6] + u * 64 + 4 * c4;
    f32x4 a0 = {0.f, 0.f, 0.f, 0.f}, a1 = a0, a2 = a0;
#pragma unroll 8
    for (int i = 0; i < 64; ++i) { const int row = 256 * wave + 4 * i + rsub; const f32x4 w = *(const f32x4*)(wp + (size_t)row * 12288);
        a0 += w * sv[row]; a1 += w * sv[2048 + row]; a2 += w * sv[4096 + row]; }
#pragma unroll
    for (int e = 0; e < 4; ++e) { a0[e] += __shfl_xor(a0[e], 16); a0[e] += __shfl_xor(a0[e], 32); a1[e] += __shfl_xor(a1[e], 16); a1[e] += __shfl_xor(a1[e], 32); a2[e] += __shfl_xor(a2[e], 16); a2[e] += __shfl_xor(a2[e], 32); }
    if (lane < 16) {
#pragma unroll
        for (int e = 0; e < 4; ++e) { red[(wave * 3 + 0) * 64 + 4 * c4 + e] = a0[e]; red[(wave * 3 + 1) * 64 + 4 * c4 + e] = a1[e]; red[(wave * 3 + 2) * 64 + 4 * c4 + e] = a2[e]; } }
    __syncthreads();
    if (tid < 192) { const int type = tid >> 6, cc = tid & 63; float s = a.in[7][u * 64 + cc];
#pragma unroll
        for (int w = 0; w < 8; ++w) s += red[(w * 3 + type) * 64 + cc];
        mod[type * 12288 + u * 64 + cc] = s; }
    __syncthreads();
}
__device__ __forceinline__ void h3_unit(KA a, int u, int lane) {
    const float* w1 = a.in[15]; const float* w2 = a.in[17]; const float* w3 = a.in[19];
    const float fq = a.in[22][lane], b1 = a.in[16][lane], b2 = a.in[18][lane], b3 = a.in[20][lane];
    float* h3 = (float*)(a.ws + WS_H3);
    for (int q = 0; q < 16; ++q) {
        const int pg = u * 16 + q; const int L = pg < 256 ? 256 : 4096; const int pos = pg < 256 ? pg : pg - 256;
        const float t = (float)pos / (float)(L - 1);
        float z = 0.f;
        if (lane == 0) z = t;
        else if (lane <= 32) { const int m = (lane - 1) & 15; const float fr = 1e-4f + (float)m * ((15.0f - 1e-4f) / 15.0f);
            const float ang = ((float)(6.283185307179586 / (double)L) * (float)pos) * fr; z = lane <= 16 ? cosf(ang) : -sinf(ang); }
        float s = 0.f;
#pragma unroll
        for (int k = 0; k < 33; ++k) s += rdlane(z, k) * w1[k * 64 + lane];
        const float h1 = sinf(fq * (s + b1));
        s = 0.f;
#pragma unroll 16
        for (int k = 0; k < 64; ++k) s += rdlane(h1, k) * w2[k * 64 + lane];
        const float h2 = sinf(fq * (s + b2));
        s = 0.f;
#pragma unroll 16
        for (int k = 0; k < 64; ++k) s += rdlane(h2, k) * w3[k * 64 + lane];
        h3[(size_t)pg * 64 + lane] = sinf(fq * (s + b3));
    }
}
__device__ __forceinline__ void split8(const f32x4 p, const f32x4 q, bf16x8& hi, bf16x8& lo) {
    const unsigned h0 = pkbf(p.x, p.y), h1 = pkbf(p.z, p.w), h2 = pkbf(q.x, q.y), h3 = pkbf(q.z, q.w);
    const unsigned l0 = pkbf(p.x - pg8::bflo(h0), p.y - pg8::bfhi(h0)), l1 = pkbf(p.z - pg8::bflo(h1), p.w - pg8::bfhi(h1));
    const unsigned l2 = pkbf(q.x - pg8::bflo(h2), q.y - pg8::bfhi(h2)), l3 = pkbf(q.z - pg8::bflo(h3), q.w - pg8::bfhi(h3));
    const v4u hv = {h0, h1, h2, h3}, lv = {l0, l1, l2, l3};
    hi = __builtin_bit_cast(bf16x8, hv); lo = __builtin_bit_cast(bf16x8, lv);
}
__device__ __forceinline__ void filt_unit(KA a, int fu, int lane) {
    const int set = fu < 4096 ? 1 : 0; const int f = set ? fu : fu - 4096;
    const int pb = set ? ((f >> 9) << 3) + (f & 7) : (f & 3), cb = set ? (f >> 3) & 63 : f >> 2;
    const int L = set ? 4096 : 256;
    const int n = lane & 31, kg = lane >> 5;
    const float* w4 = a.in[21];
    const float* h3 = (const float*)(a.ws + WS_H3) + (size_t)((set ? 256 : 0) + pb * 64) * 64;
    bf16x8 Bhi[2][4], Blo[2][4];
#pragma unroll
    for (int nt = 0; nt < 2; ++nt)
#pragma unroll
        for (int ks = 0; ks < 4; ++ks) { const float* q = h3 + (size_t)(32 * nt + n) * 64 + 16 * ks + 8 * kg;
            split8(*(const f32x4*)q, *(const f32x4*)(q + 4), Bhi[nt][ks], Blo[nt][ks]); }
    f32x16 acc[2][2];
#pragma unroll
    for (int mt = 0; mt < 2; ++mt)
#pragma unroll
        for (int nt = 0; nt < 2; ++nt)
#pragma unroll
            for (int q = 0; q < 16; ++q) acc[mt][nt][q] = 0.f;
#pragma unroll
    for (int mt = 0; mt < 2; ++mt)
#pragma unroll
        for (int ks = 0; ks < 4; ++ks) { const float* q = w4 + (size_t)(16 * ks + 8 * kg) * 4096 + cb * 64 + 32 * mt + n;
            const f32x4 p0 = {q[0], q[4096], q[2 * 4096], q[3 * 4096]}, p1 = {q[4 * 4096], q[5 * 4096], q[6 * 4096], q[7 * 4096]};
            bf16x8 Ahi, Alo; split8(p0, p1, Ahi, Alo);
#pragma unroll
            for (int nt = 0; nt < 2; ++nt) {
                acc[mt][nt] = __builtin_amdgcn_mfma_f32_32x32x16_bf16(Alo, Bhi[nt][ks], acc[mt][nt], 0, 0, 0);
                acc[mt][nt] = __builtin_amdgcn_mfma_f32_32x32x16_bf16(Ahi, Blo[nt][ks], acc[mt][nt], 0, 0, 0);
                acc[mt][nt] = __builtin_amdgcn_mfma_f32_32x32x16_bf16(Ahi, Bhi[nt][ks], acc[mt][nt], 0, 0, 0); } }
    bf16* R = (bf16*)(a.ws + (set ? WS_FILT1 : WS_FILT0));
    float* part = (float*)(a.ws + WS_PART) + (set ? 4 * 4096 : 0) + pb * 4096;
    const float tstep = 1.0f / (float)(L - 1);
#pragma unroll
    for (int mt = 0; mt < 2; ++mt)
#pragma unroll
        for (int reg = 0; reg < 16; ++reg) {
            const int col = cb * 64 + 32 * mt + (reg & 3) + 8 * (reg >> 2) + 4 * kg; const int o = col >> 11, dir = (col >> 10) & 1, c = col & 1023;
            const float delta = fabsf(-3.0701134573253945f + (float)c * ((-15.350567286626973f + 3.0701134573253945f) / 1023.0f));
            bf16* Rrow = R + (size_t)(o * 1024 + c) * (2 * L);
            float asum = 0.f;
#pragma unroll
            for (int nt = 0; nt < 2; ++nt) { const int pos = pb * 64 + 32 * nt + n;
                float kv = acc[mt][nt][reg] * __expf(-((float)pos * tstep) * delta);
                const bool skip = (dir == 1 && pos == 0);
                if (skip) kv = 0.f;
                const int x = skip ? 2 * L - 1 : (dir ? L - 1 + pos : L - 1 - pos);
                Rrow[x] = f2bf(kv); asum += fabsf(kv); }
            asum += __int_as_float(__builtin_amdgcn_update_dpp(0, __float_as_int(asum), 0xB1, 0xf, 0xf, false));
            asum += __int_as_float(__builtin_amdgcn_update_dpp(0, __float_as_int(asum), 0x4E, 0xf, 0xf, false));
            asum += __int_as_float(__builtin_amdgcn_update_dpp(0, __float_as_int(asum), 0x141, 0xf, 0xf, false));
            asum += __int_as_float(__builtin_amdgcn_update_dpp(0, __float_as_int(asum), 0x140, 0xf, 0xf, false));
            const float s0 = rdlane(asum, 0) + rdlane(asum, 16), s1 = rdlane(asum, 32) + rdlane(asum, 48);
            if (lane == 0) { part[col] = s0; part[col + 4] = s1; }
        }
}

__device__ __forceinline__ void s5_unit(KA a, LAS unsigned char* wl, int kind, int ps, int dir, int g, int lane) {
    const int p0 = lane & 31, h = lane >> 5;
    const bf16* ssm = (const bf16*)(a.ws + WS_SSM);
    bf16* ypart = (bf16*)(a.ws + WS_A) + (size_t)dir * 16384 * 1024;
    float* sloc = (float*)(a.ws + WS_SLOC);
    const float dt = __expf(a.in[27][dir * 64 + g]);
    float lr[2], li[2], sr[2], si[2];
    bf16x8 Bf[2][2];
#pragma unroll
    for (int e = 0; e < 2; ++e) { const int pp = p0 + 32 * e; const int idx = (dir * 64 + g) * 64 + pp;
        const float are = fminf(a.in[25][idx], -1e-4f), aim = a.in[26][idx];
        const float mag = __expf(are * dt); lr[e] = mag * cosf(aim * dt); li[e] = mag * sinf(aim * dt);
        const float den = 1.0f / (are * are + aim * aim);
        const float qre = ((lr[e] - 1.0f) * are + li[e] * aim) * den, qim = (li[e] * are - (lr[e] - 1.0f) * aim) * den;
        const f32x4 br0 = *(const f32x4*)(a.in[28] + (size_t)idx * 16 + 8 * h), br1 = *(const f32x4*)(a.in[28] + (size_t)idx * 16 + 8 * h + 4);
        const f32x4 bi0 = *(const f32x4*)(a.in[29] + (size_t)idx * 16 + 8 * h), bi1 = *(const f32x4*)(a.in[29] + (size_t)idx * 16 + 8 * h + 4);
        const f32x4 re0 = br0 * qre - bi0 * qim, re1 = br1 * qre - bi1 * qim, im0 = bi0 * qre + br0 * qim, im1 = bi1 * qre + br1 * qim;
        const v4u wr_ = {pkbf(re0.x, re0.y), pkbf(re0.z, re0.w), pkbf(re1.x, re1.y), pkbf(re1.z, re1.w)};
        const v4u wi_ = {pkbf(im0.x, im0.y), pkbf(im0.z, im0.w), pkbf(im1.x, im1.y), pkbf(im1.z, im1.w)};
        Bf[0][e] = __builtin_bit_cast(bf16x8, wr_); Bf[1][e] = __builtin_bit_cast(bf16x8, wi_);
        sr[e] = 0.f; si[e] = 0.f; }
    bf16x8 Cf[4];
    if (kind != 1) {
        const int ci = lane & 15, kq = lane >> 4;
#pragma unroll
        for (int ks = 0; ks < 4; ++ks) { const size_t o = (size_t)((dir * 64 + g) * 16 + ci) * 64 + 16 * ks + 4 * kq;
            const f32x4 cr = *(const f32x4*)(a.in[30] + o), cm = *(const f32x4*)(a.in[31] + o);
            const v4u w = {pkbf(cr.x, -cm.x), pkbf(cr.y, -cm.y), pkbf(cr.z, -cm.z), pkbf(cr.w, -cm.w)};
            Cf[ks] = __builtin_bit_cast(bf16x8, w); }
    }
    int base0, Lq, segoff;
    if (kind == 0) { base0 = 2 * ps * 256; Lq = 256; segoff = 0; } else { base0 = 8192; Lq = 4096; segoff = 256 * ps; }
    const int seqstride = kind == 0 ? 256 : 4096;
    if (kind == 2) {
#pragma unroll
        for (int e = 0; e < 2; ++e) { const int pp = p0 + 32 * e; const int sidx = ((h * 2 + dir) * 64 + g) * 64 + pp;
            float xr = a.in[2][sidx], xi = a.in[3][sidx];
            float pr = lr[e], pi = li[e];
#pragma unroll
            for (int q = 0; q < 8; ++q) { const float nr = pr * pr - pi * pi, ni = 2.0f * pr * pi; pr = nr; pi = ni; }
            for (int j = 0; j < ps; ++j) { const float* sl = sloc + ((size_t)(((h * 2 + dir) * 64 + g) * 16 + j) * 64 + pp) * 2;
                const float nr = pr * xr - pi * xi + sl[0], ni = pr * xi + pi * xr + sl[1]; xr = nr; xi = ni; }
            sr[e] = xr; si[e] = xi; }
    }
    const int seqA = (p0 >> 2) & 1, tokA = 4 * (p0 >> 3) + (p0 & 3);
    LAS unsigned* wlu = (LAS unsigned*)wl;
    const int lp0 = segoff + tokA;
    const bf16* arow = ssm + (size_t)(base0 + seqA * seqstride + (dir ? Lq - 1 - lp0 : lp0)) * 1024 + 16 * g + 8 * h;
    const long astep = dir ? -16 * 1024 : 16 * 1024;
    bf16x8 af = *(const bf16x8*)arow, af1 = *(const bf16x8*)(arow + astep);
    for (int st = 0; st < 16; ++st) {
        bf16x8 af2 = af1; if (st < 14) af2 = *(const bf16x8*)(arow + (st + 2) * astep);
        f32x16 D[2][2];
#pragma unroll
        for (int ri = 0; ri < 2; ++ri)
#pragma unroll
            for (int e = 0; e < 2; ++e) { f32x16 z;
#pragma unroll
                for (int q = 0; q < 16; ++q) z[q] = 0.f;
                D[ri][e] = __builtin_amdgcn_mfma_f32_32x32x16_bf16(af, Bf[ri][e], z, 0, 0, 0); }
        asm volatile("" ::: "memory");
#pragma unroll
        for (int tok = 0; tok < 16; ++tok) {
#pragma unroll
            for (int e = 0; e < 2; ++e) { const float nr = lr[e] * sr[e] - li[e] * si[e] + D[0][e][tok], ni = lr[e] * si[e] + li[e] * sr[e] + D[1][e][tok]; sr[e] = nr; si[e] = ni;
                if (kind != 1) wlu[(h * 16 + tok) * 68 + p0 + 32 * e] = pkbf(nr, ni); }
        }
        if (kind != 1) {
            LDS_FENCE();
            const int ci = lane & 15, kq = lane >> 4;
#pragma unroll
            for (int m = 0; m < 2; ++m) { pg8::f32x4 acc = {0.f, 0.f, 0.f, 0.f};
#pragma unroll
                for (int ks = 0; ks < 4; ++ks) { const bf16x8 av = *(const LAS bf16x8*)(wl + (16 * m + ci) * 272 + 64 * ks + 16 * kq);
                    acc = __builtin_amdgcn_mfma_f32_16x16x32_bf16(Cf[ks], av, acc, 0, 0, 0); }
                { const int lp = segoff + 16 * st + ci; const int row = base0 + m * seqstride + (dir ? Lq - 1 - lp : lp);
                    v2u o; o.x = pkbf(acc[0], acc[1]); o.y = pkbf(acc[2], acc[3]);
                    *(v2u*)(ypart + (size_t)row * 1024 + 16 * g + 4 * kq) = o; } }
            LDS_FENCE();
        }
        af = af1; af1 = af2;
    }
#pragma unroll
    for (int e = 0; e < 2; ++e) { const int pp = p0 + 32 * e;
        if (kind == 0) { const int b = 2 * ps + h; const size_t o = (size_t)((b * 2 + dir) * 64 + g) * 64 + pp;
            a.out[(size_t)33554432 + o] = sr[e]; a.out[(size_t)33554432 + 262144 + o] = si[e]; }
        else if (kind == 1) { float* sl = sloc + ((size_t)(((h * 2 + dir) * 64 + g) * 16 + ps) * 64 + pp) * 2; sl[0] = sr[e]; sl[1] = si[e]; } }
}

template <int SET> __device__ __forceinline__ int zidx(int b, int t) { return SET ? b * 4608 + (t >> 6) * 72 + (t & 63) : b * 264 + t; }
template <int SET> struct HyIn { static constexpr int NG = SET ? 2 : 1; v4u q0[3], q1[3]; float hp[3], hn[3], sw0[3], sw1[3], sw2[3], sbv[3]; v4u Rw[2][NG]; v2u Rx[2][NG]; float psum[2], hbias[2]; };
template <int SET> __device__ __forceinline__ void hy_load(KA a, int c, int tid, HyIn<SET>& I) {
    constexpr int L = SET ? 4096 : 256, NG = SET ? 2 : 1, NPB = SET ? 64 : 4;
    const int lane = tid & 63; const int tokbase = SET ? 8192 : 0;
    const bf16* hyT = (const bf16*)(a.ws + WS_HYT);
    const int t0 = tid * 16; const bool first = (t0 % L) == 0, last = ((t0 + 16) % L) == 0;
#pragma unroll
    for (int chn = 0; chn < 3; ++chn) { const int ch = chn * 1024 + c; const bf16* row = hyT + (size_t)ch * 16384 + tokbase + t0;
        I.q0[chn] = *(const v4u*)row; I.q1[chn] = *(const v4u*)(row + 8); I.hp[chn] = first ? 0.f : bf2f(row[-1]); I.hn[chn] = last ? 0.f : bf2f(row[16]);
        I.sw0[chn] = a.in[13][ch]; I.sw1[chn] = a.in[13][3072 + ch]; I.sw2[chn] = a.in[13][6144 + ch]; I.sbv[chn] = a.in[14][ch]; }
#pragma unroll
    for (int o = 0; o < 2; ++o) { const bf16* R = (const bf16*)(a.ws + (SET ? WS_FILT1 : WS_FILT0)) + (size_t)(o * 1024 + c) * (2 * L);
#pragma unroll
        for (int gi = 0; gi < NG; ++gi) { const int m8 = tid + gi * NTHR;
            if (m8 < 2 * L / 8) { I.Rw[o][gi] = *(const v4u*)(R + 8 * m8); I.Rx[o][gi] = *(const v2u*)(R + 8 * m8 + 8); } else { I.Rw[o][gi] = (v4u){0u, 0u, 0u, 0u}; I.Rx[o][gi] = (v2u){0u, 0u}; } }
        const float* part = (const float*)(a.ws + WS_PART) + (SET ? 4 * 4096 : 0); float ps = 0.f;
#pragma unroll
        for (int i0 = 0; i0 < 2 * NPB; i0 += 64) { const int i = i0 + lane; if (i < 2 * NPB) { const int dir = i / NPB, pb = i % NPB; ps += part[pb * 4096 + o * 2048 + dir * 1024 + c]; } }
        I.psum[o] = ps; I.hbias[o] = a.in[23][o * 1024 + c]; }
}
template <int SET> __device__ __forceinline__ void hyena_unit(KA a, LAS unsigned char* lds, int c, int tid, HyIn<SET>& I, bool has_next, int cn) {
    constexpr int L = SET ? 4096 : 256, CPB = (2 * L + 32) * 2  , ZBUF = 18432, NG = SET ? 2 : 1, NPB = SET ? 64 : 4;
    const int lane = tid & 63, wave = __builtin_amdgcn_readfirstlane(tid >> 6);
    const int tokbase = SET ? 8192 : 0;
    const bf16* hyT = (const bf16*)(a.ws + WS_HYT);
    LAS bf16* Z0 = (LAS bf16*)lds; LAS bf16* Z1 = (LAS bf16*)(lds + ZBUF); LAS bf16* X1 = (LAS bf16*)(lds + 2 * ZBUF); LAS bf16* X2 = (LAS bf16*)(lds + 3 * ZBUF);
    LAS unsigned char* cpy = lds + 4 * ZBUF;
    const int t0 = tid * 16; const int zi0 = zidx<SET>(t0 / L, t0 % L);
    const bool first = (t0 % L) == 0, last = ((t0 + 16) % L) == 0;
#pragma unroll
    for (int chn = 0; chn < 3; ++chn) {
        float f[18];
        f[0] = I.hp[chn]; f[17] = I.hn[chn];
        f[1] = pg8::bflo(I.q0[chn].x); f[2] = pg8::bfhi(I.q0[chn].x); f[3] = pg8::bflo(I.q0[chn].y); f[4] = pg8::bfhi(I.q0[chn].y); f[5] = pg8::bflo(I.q0[chn].z); f[6] = pg8::bfhi(I.q0[chn].z); f[7] = pg8::bflo(I.q0[chn].w); f[8] = pg8::bfhi(I.q0[chn].w);
        f[9] = pg8::bflo(I.q1[chn].x); f[10] = pg8::bfhi(I.q1[chn].x); f[11] = pg8::bflo(I.q1[chn].y); f[12] = pg8::bfhi(I.q1[chn].y); f[13] = pg8::bflo(I.q1[chn].z); f[14] = pg8::bfhi(I.q1[chn].z); f[15] = pg8::bflo(I.q1[chn].w); f[16] = pg8::bfhi(I.q1[chn].w);
        float o[16];
#pragma unroll
        for (int i = 0; i < 16; ++i) o[i] = I.sw0[chn] * f[i] + I.sw1[chn] * f[i + 1] + I.sw2[chn] * f[i + 2] + I.sbv[chn];
        const v4u r0 = {pkbf(o[0], o[1]), pkbf(o[2], o[3]), pkbf(o[4], o[5]), pkbf(o[6], o[7])}, r1 = {pkbf(o[8], o[9]), pkbf(o[10], o[11]), pkbf(o[12], o[13]), pkbf(o[14], o[15])};
        LAS bf16* dst = (chn == 0 ? X1 : (chn == 1 ? X2 : Z0)) + zi0;
        *(LAS v4u*)dst = r0; *(LAS v4u*)(dst + 8) = r1;
    }
    const int kh = lane >> 5, n = lane & 31;
    if (tid < 9) *(LAS v4u*)(cpy + 4 * CPB + 16 * tid) = (v4u){0u, 0u, 0u, 0u};
#pragma unroll
    for (int o = 0; o < 2; ++o) {
#pragma unroll
        for (int gi = 0; gi < NG; ++gi) { const int m8 = tid + gi * NTHR;
            if (m8 < 2 * L / 8) { const v4u w = I.Rw[o][gi]; const v2u x = I.Rx[o][gi];
                const v4u c0 = w, c1 = {__builtin_amdgcn_alignbit(w.y, w.x, 16), __builtin_amdgcn_alignbit(w.z, w.y, 16), __builtin_amdgcn_alignbit(w.w, w.z, 16), __builtin_amdgcn_alignbit(x.x, w.w, 16)};
                const v4u c2 = {w.y, w.z, w.w, x.x}, c3 = {__builtin_amdgcn_alignbit(w.z, w.y, 16), __builtin_amdgcn_alignbit(w.w, w.z, 16), __builtin_amdgcn_alignbit(x.x, w.w, 16), __builtin_amdgcn_alignbit(x.y, x.x, 16)};
                *(LAS v4u*)(cpy + 16 * m8) = c0; *(LAS v4u*)(cpy + CPB + 16 * m8) = c1; *(LAS v4u*)(cpy + 2 * CPB + 16 * m8) = c2; *(LAS v4u*)(cpy + 3 * CPB + 16 * m8) = c3; } }
        const float inv = 1.0f / wave_sum(I.psum[o]), bias = I.hbias[o];
        __syncthreads();
        if (o == 1 && has_next) hy_load<SET>(a, cn, tid, I);
        const LAS bf16* Zin = o == 0 ? Z0 : Z1; LAS bf16* Zout = o == 0 ? Z1 : Z0; const LAS bf16* XG = o == 0 ? X1 : X2;
        f32x16 acc, acc2;
#pragma unroll
        for (int q = 0; q < 16; ++q) { acc[q] = 0.f; acc2[q] = 0.f; }
        int idx0;
        if (SET) {
            const int mt = wave & 1, nt = wave >> 1, b = nt >> 1, h1 = nt & 1;
            const int tt0 = 32 * mt + n; const int r = (L - 1 - tt0) & 3;
            const LAS unsigned char* cp = cpy + r * CPB; const int ebase = (L - 1 - tt0 - r) + 8 * kh;
            const int t1 = 32 * h1 + n; const int dlo = h1 ? -31 : -63;
            const LAS bf16* zbase = Zin + b * 4608 + 8 * kh; const LAS bf16* zzero = (const LAS bf16*)(cpy + 4 * CPB) + 8 * kh;
            v4u Aq[4], Bq[4];
            { const LAS unsigned char* ap = cp + 2 * (ebase - 64 * dlo);
                const int s1 = t1 - dlo; const LAS bf16* zp = (unsigned)s1 < 64u ? zbase + 72 * s1 : zzero;
#pragma unroll
                for (int ks = 0; ks < 4; ++ks) { const v2u a0 = *(const volatile LAS v2u*)(ap + 32 * ks), a1 = *(const volatile LAS v2u*)(ap + 32 * ks + 8); Aq[ks] = (v4u){a0.x, a0.y, a1.x, a1.y}; Bq[ks] = *(const LAS v4u*)(zp + 16 * ks); } }
#pragma unroll 5
            for (int di = 0; di < 95; ++di) {
                const int d = dlo + di; const int dn = di < 94 ? d + 1 : d;
                v4u An[4], Bn[4];
                { const LAS unsigned char* ap = cp + 2 * (ebase - 64 * dn);
                    const int s1 = t1 - dn; const LAS bf16* zp = (unsigned)s1 < 64u ? zbase + 72 * s1 : zzero;
#pragma unroll
                    for (int ks = 0; ks < 4; ++ks) { const v2u a0 = *(const volatile LAS v2u*)(ap + 32 * ks), a1 = *(const volatile LAS v2u*)(ap + 32 * ks + 8); An[ks] = (v4u){a0.x, a0.y, a1.x, a1.y}; Bn[ks] = *(const LAS v4u*)(zp + 16 * ks); } }
#pragma unroll
                for (int ks = 0; ks < 4; ++ks) {
                    if (ks & 1) acc2 = __builtin_amdgcn_mfma_f32_32x32x16_bf16(__builtin_bit_cast(bf16x8, Aq[ks]), __builtin_bit_cast(bf16x8, Bq[ks]), acc2, 0, 0, 0);
                    else acc = __builtin_amdgcn_mfma_f32_32x32x16_bf16(__builtin_bit_cast(bf16x8, Aq[ks]), __builtin_bit_cast(bf16x8, Bq[ks]), acc, 0, 0, 0);
                }
#pragma unroll
                for (int ks = 0; ks < 4; ++ks) { Aq[ks] = An[ks]; Bq[ks] = Bn[ks]; }
            }
            idx0 = b * 4608 + 72 * t1 + 32 * mt + 4 * kh;
        } else {
            const int t = 32 * wave + n; const int r = (L - 1 - t) & 3;
            const LAS unsigned char* ap = cpy + r * CPB + 2 * ((L - 1 - t - r) + 8 * kh);
            const LAS bf16* zp = Zin + n * 264 + 8 * kh;
#pragma unroll
            for (int ks = 0; ks < 16; ++ks) {
                const v2u a0 = *(const volatile LAS v2u*)(ap + 32 * ks), a1 = *(const volatile LAS v2u*)(ap + 32 * ks + 8);
                const v4u bv = *(const LAS v4u*)(zp + 16 * ks);
                const v4u av = {a0.x, a0.y, a1.x, a1.y};
                if (ks & 1) acc2 = __builtin_amdgcn_mfma_f32_32x32x16_bf16(__builtin_bit_cast(bf16x8, av), __builtin_bit_cast(bf16x8, bv), acc2, 0, 0, 0);
                else acc = __builtin_amdgcn_mfma_f32_32x32x16_bf16(__builtin_bit_cast(bf16x8, av), __builtin_bit_cast(bf16x8, bv), acc, 0, 0, 0);
            }
            idx0 = n * 264 + 32 * wave + 4 * kh;
        }
#pragma unroll
        for (int reg = 0; reg < 16; ++reg) { const int idx = idx0 + (reg & 3) + 8 * (reg >> 2);
            const float z = bf2f(Zin[idx]), xg = bf2f(XG[idx]);
            Zout[idx] = f2bf(xg * ((acc[reg] + acc2[reg]) * inv + bias * z)); }
        __syncthreads();
    }
    { bf16* row = (bf16*)(a.ws + WS_YHT) + (size_t)c * 16384 + tokbase + t0;
        *(v4u*)row = *(const LAS v4u*)(Z0 + zi0); *(v4u*)(row + 8) = *(const LAS v4u*)(Z0 + zi0 + 8); }
    __syncthreads();
}

__device__ __forceinline__ void combine_items(KA a, int gthr, int nthr) {
    const bf16* ssm = (const bf16*)(a.ws + WS_SSM); const bf16* yf = (const bf16*)(a.ws + WS_A); const bf16* yb = yf + (size_t)16384 * 1024;
    bf16* G = (bf16*)(a.ws + WS_G); const float* dd = a.in[32];
    const bool inv = (nthr & 127) == 0;
    f32x4 d0 = *(const f32x4*)(dd + (gthr & 127) * 8), d1 = *(const f32x4*)(dd + (gthr & 127) * 8 + 4);
#pragma unroll 4
    for (int it = gthr; it < 16384 * 128; it += nthr) { const size_t off = (size_t)it * 8; const int col = (it & 127) * 8;
        const v4u u = *(const v4u*)(ssm + off), f = *(const v4u*)(yf + off), b = *(const v4u*)(yb + off);
        f32x4 u0, u1, f0, f1, b0, b1; pg8::unpack8(u, u0, u1); pg8::unpack8(f, f0, f1); pg8::unpack8(b, b0, b1);
        if (!inv) { d0 = *(const f32x4*)(dd + col); d1 = *(const f32x4*)(dd + col + 4); }
        f32x4 y0 = u0 * d0 + f0 + b0, y1 = u1 * d1 + f1 + b1;
#pragma unroll
        for (int e = 0; e < 4; ++e) { y0[e] = gelu_tanh(y0[e]); y1[e] = gelu_tanh(y1[e]); }
        *(v4u*)(G + off) = pg8::pack8(y0, y1); }
}
__device__ __forceinline__ void yh_transpose_item(KA a, int it, LAS bf16* scr, int lane) {
    const int cb = it & 15, tb = it >> 4;
    const bf16* src = (const bf16*)(a.ws + WS_YHT) + (size_t)(cb * 64) * 16384 + tb * 64;
    bf16* dst = (bf16*)(a.ws + WS_YH) + (size_t)(tb * 64) * 1024 + cb * 64;
#pragma unroll
    for (int i = 0; i < 8; ++i) { const int r = 8 * i + (lane >> 3), ck = lane & 7; const v4u v = *(const v4u*)(src + (size_t)r * 16384 + 8 * ck);
        LAS unsigned* s = (LAS unsigned*)(scr + r * 66 + 8 * ck); s[0] = v.x; s[1] = v.y; s[2] = v.z; s[3] = v.w; }
    LDS_FENCE();
#pragma unroll
    for (int i = 0; i < 8; ++i) { const int t = 8 * i + (lane >> 3), ck = lane & 7;
        unsigned short e[8];
#pragma unroll
        for (int j = 0; j < 8; ++j) e[j] = scr[(8 * ck + j) * 66 + t];
        const v4u o = {(unsigned)e[0] | ((unsigned)e[1] << 16), (unsigned)e[2] | ((unsigned)e[3] << 16), (unsigned)e[4] | ((unsigned)e[5] << 16), (unsigned)e[6] | ((unsigned)e[7] << 16)};
        *(v4u*)(dst + (size_t)t * 1024 + 8 * ck) = o; }
    LDS_FENCE();
}

template <int NX> __device__ __forceinline__ void conv_strip(const bf16* up, bf16* act, const float* cw, const float* cbias, int CN, int ca0,
        int tok0, int mstride, int S, int s0, int ns, bool xl, bool xr, int j0) {
    const int ld = 2 * CN;
    f32x4 wa[3][NX], wb[3][NX];
#pragma unroll
    for (int m = 0; m < 3; ++m)
#pragma unroll
        for (int x = 0; x < NX; ++x) { const int tap = NX == 3 ? m * 3 + x : 3 + m; wa[m][x] = *(const f32x4*)(cw + tap * 11264 + ca0 + j0); wb[m][x] = *(const f32x4*)(cw + tap * 11264 + 5632 + ca0 + j0); }
    const f32x4 ba = *(const f32x4*)(cbias + ca0 + j0), bb = *(const f32x4*)(cbias + 5632 + ca0 + j0);
    v2u ring[8][NX][2];
    const int slast = s0 + ns;
#define CONV_LOAD(dst, sidx) do { const int s_ = (sidx); const bool vs_ = s_ >= 0 && s_ < S && s_ <= slast; \
        _Pragma("unroll") for (int x = 0; x < NX; ++x) { const bool v_ = vs_ && (NX == 1 || (x == 0 ? xl : (x == 2 ? xr : true))); \
            if (v_) { const bf16* q_ = up + (size_t)(tok0 + s_ * mstride + (NX == 3 ? x - 1 : 0)) * ld + j0; dst[x][0] = *(const v2u*)q_; dst[x][1] = *(const v2u*)(q_ + CN); } \
            else { dst[x][0] = (v2u){0u, 0u}; dst[x][1] = (v2u){0u, 0u}; } } } while (0)
#pragma unroll
    for (int k = 0; k < 7; ++k) CONV_LOAD(ring[k], s0 - 1 + k);
    for (int sb = s0; sb < slast; sb += 8) {
#pragma unroll
        for (int j = 0; j < 8; ++j) { const int s = sb + j;
            CONV_LOAD(ring[(j + 7) & 7], s + 6);
            f32x4 sa = ba, sb2 = bb;
#pragma unroll
            for (int m = 0; m < 3; ++m)
#pragma unroll
                for (int x = 0; x < NX; ++x) { const v2u pa = ring[(j + m) & 7][x][0], pb = ring[(j + m) & 7][x][1];
                    const f32x4 va = {pg8::bflo(pa.x), pg8::bfhi(pa.x), pg8::bflo(pa.y), pg8::bfhi(pa.y)}, vb = {pg8::bflo(pb.x), pg8::bfhi(pb.x), pg8::bflo(pb.y), pg8::bfhi(pb.y)};
                    sa += va * wa[m][x]; sb2 += vb * wb[m][x]; }
            v2u o; o.x = pkbf(gelu_tanh(sa.x) * sb2.x, gelu_tanh(sa.y) * sb2.y); o.y = pkbf(gelu_tanh(sa.z) * sb2.z, gelu_tanh(sa.w) * sb2.w);
            *(v2u*)(act + (size_t)(tok0 + s * mstride) * CN + j0) = o; }
    }
#undef CONV_LOAD
}
__device__ __forceinline__ void conv_items(KA a, int gw, int NGW, int lane, int CN, int ca0) {
    const bf16* up = (const bf16*)(a.ws + WS_UP); bf16* act = (bf16*)(a.ws + WS_ACT);
    const float* cw = a.in[38]; const float* cbias = a.in[39];
    const int nslab = CN >> 8; const int nlat = 512 * nslab, ntot = 768 * nslab;
    for (int it = gw; it < ntot; it += NGW) {
        if (it < nlat) { const int gq = it & 63, b = (it >> 6) & 1, t = it >> 7; const int seg = t & 3, slab = t >> 2;
            conv_strip<3>(up, act, cw, cbias, CN, ca0, 8192 + b * 4096 + gq, 64, 64, seg * 16, 16, gq > 0, gq < 63, slab * 256 + 4 * lane); }
        else { const int r = it - nlat; const int slab = r % nslab, t = r / nslab; const int seg = t & 7, sq = t >> 3;
            conv_strip<1>(up, act, cw, cbias, CN, ca0, sq * 256, 1, 256, seg * 32, 32, false, false, slab * 256 + 4 * lane); }
    }
}

#define XB_TMO      128
#define XB_XCNT(j)  (256  + 64 * (j))
#define XB_XSUB(j)  (1280 + 64 * (j))
#define XB_XGEN(j)  (2304 + 64 * (j))
#define XB_TOP      3328
#define XB_TOPGEN   3392
#define XCD_BAR_WORDS 3456
#define XB_SPIN_CAP (1u << 18)

__device__ __forceinline__ unsigned xb_ld(unsigned* p)              { return __hip_atomic_load(p, __ATOMIC_RELAXED, __HIP_MEMORY_SCOPE_AGENT); }
__device__ __forceinline__ unsigned xb_add(unsigned* p, unsigned v) { return __hip_atomic_fetch_add(p, v, __ATOMIC_RELAXED, __HIP_MEMORY_SCOPE_AGENT); }
__device__ __forceinline__ unsigned xb_xcc_id() { return (unsigned)__builtin_amdgcn_s_getreg((3 << 11) | 20) & 0xFu; }
#define XB_SPIN(cond, bar) do { unsigned _sp = 0; while (cond) { __builtin_amdgcn_s_sleep(1); \
    if ((++_sp & 255u) == 0u) { if (xb_ld(&(bar)[XB_TMO])) break; if (_sp > XB_SPIN_CAP) { atomicAdd(&(bar)[XB_TMO], 1u); break; } } } } while (0)

struct XcdBarrier {
    unsigned* bar; unsigned x;
    volatile LAS unsigned* st;
};

__device__ __forceinline__ XcdBarrier xcd_barrier_post(unsigned* bar, volatile LAS unsigned* st) {
    XcdBarrier b; b.bar = bar; b.x = xb_xcc_id(); b.st = st;
    if (threadIdx.x == 0) (void)xb_add(&bar[XB_XCNT(b.x)], 1u);
    return b;
}
__device__ __forceinline__ void xcd_barrier_complete(unsigned* bar, unsigned x, unsigned& nloc, unsigned& nx) {
    const unsigned G = gridDim.x * gridDim.y * gridDim.z;
    unsigned sum, cnt, mine, sp = 0u;
    for (;;) {
        sum = 0u; cnt = 0u; mine = 0u;
#pragma unroll
        for (unsigned j = 0; j < 16; ++j) { const unsigned c = xb_ld(&bar[XB_XCNT(j)]); sum += c; cnt += (c > 0u) ? 1u : 0u; mine = (j == x) ? c : mine; }
        if (sum == G) break;
        __builtin_amdgcn_s_sleep(1);
        if ((++sp & 255u) == 0u) { if (xb_ld(&bar[XB_TMO])) break; if (sp > XB_SPIN_CAP) { atomicAdd(&bar[XB_TMO], 1u); break; } }
    }
    nloc = mine > 0u ? mine : 1u; nx = cnt > 0u ? cnt : 1u;
}

__device__ __forceinline__ void xcd_barrier(const XcdBarrier& b) {
    asm volatile("s_waitcnt vmcnt(0)" ::: "memory");
    __syncthreads();
    if (threadIdx.x == 0) {
        unsigned* bar = b.bar;
        __builtin_amdgcn_s_waitcnt(0);
        unsigned nloc = b.st[0], nx = b.st[1];
        if (nloc == 0u) { xcd_barrier_complete(bar, b.x, nloc, nx); b.st[0] = nloc; b.st[1] = nx; }
        const unsigned old = xb_add(&bar[XB_XSUB(b.x)], 1u);
        const unsigned gen = old / nloc;
        if (old + 1u == (gen + 1u) * nloc) {
            __builtin_amdgcn_fence(__ATOMIC_RELEASE, "agent");
            asm volatile("s_waitcnt vmcnt(0)" ::: "memory");
            const unsigned og = xb_add(&bar[XB_TOP], 1u);
            const unsigned tg = og / nx;
            if (og + 1u == (tg + 1u) * nx) xb_add(&bar[XB_TOPGEN], 1u);
            else XB_SPIN(xb_ld(&bar[XB_TOPGEN]) == tg, bar);
            __builtin_amdgcn_fence(__ATOMIC_ACQUIRE, "agent");
            xb_add(&bar[XB_XGEN(b.x)], 1u);
            asm volatile("s_waitcnt vmcnt(0)" ::: "memory");
        } else {
            XB_SPIN(xb_ld(&bar[XB_XGEN(b.x)]) == gen, bar);
            __builtin_amdgcn_fence(__ATOMIC_ACQUIRE, "agent");
            asm volatile("s_waitcnt vmcnt(0)" ::: "memory");
        }
    }
    __syncthreads();
}


struct TrItem { const float* src; int N; bf16* dst; int ldk; };
__device__ __forceinline__ void tr_load(const TrItem& t, f32x4 (&v)[16], int lane) {
    const int rs = lane >> 4, c4 = lane & 15;
#pragma unroll
    for (int i = 0; i < 16; ++i) v[i] = *(const f32x4*)(t.src + (size_t)(4 * i + rs) * t.N + 4 * c4);
}
__device__ __forceinline__ void tr_lds_write(const f32x4 (&v)[16], LAS float* scr, int lane) {
    const int rs = lane >> 4, c4 = lane & 15;
#pragma unroll
    for (int i = 0; i < 16; ++i) { LAS float* d = scr + (4 * i + rs) * 65 + 4 * c4; d[0] = v[i].x; d[1] = v[i].y; d[2] = v[i].z; d[3] = v[i].w; }
}
__device__ __forceinline__ void tr_store(const TrItem& t, const LAS float* scr, int lane) {
    const int c = lane & 7, ns = lane >> 3;
#pragma unroll
    for (int j = 0; j < 8; ++j) { const int n = ns + 8 * j; const LAS float* q = scr + (8 * c) * 65 + n;
        v4u o; o.x = pkbf(q[0 * 65], q[1 * 65]); o.y = pkbf(q[2 * 65], q[3 * 65]); o.z = pkbf(q[4 * 65], q[5 * 65]); o.w = pkbf(q[6 * 65], q[7 * 65]);
        *(v4u*)(t.dst + (size_t)n * t.ldk + 8 * c) = o; }
}
__device__ __forceinline__ TrItem p0_item(KA a, unsigned char* ws, int r) {
    const float* W; int N, ldk, n0, k0; bf16* WT;
    if (r < 4096) { W = a.in[11]; N = 8192; WT = (bf16*)(ws + WS_WIN); ldk = 2048; n0 = (r & 127) * 64; k0 = (r >> 7) * 64; }
    else if ((r -= 4096) < 256) { W = a.in[33]; N = 1024; WT = (bf16*)(ws + WS_WGLU); ldk = 1024; n0 = (r & 15) * 64; k0 = (r >> 4) * 64; }
    else if ((r -= 256) < 512) { W = a.in[24]; N = 2048; WT = (bf16*)(ws + WS_WBH); ldk = 1024; n0 = (r & 31) * 64; k0 = (r >> 5) * 64; }
    else if ((r -= 512) < 512) { W = a.in[35]; N = 2048; WT = (bf16*)(ws + WS_WBS); ldk = 1024; n0 = (r & 31) * 64; k0 = (r >> 5) * 64; }
    else { r -= 512; W = a.in[36]; N = 2048; WT = (bf16*)(ws + WS_WOUT); ldk = 2048; n0 = (r & 31) * 64; k0 = (r >> 5) * 64; }
    TrItem t; t.src = W + (size_t)k0 * N + n0; t.N = N; t.dst = WT + (size_t)n0 * ldk + k0; t.ldk = ldk; return t;
}
__device__ __forceinline__ TrItem p9_item(KA a, unsigned char* ws, int it) {
    TrItem t;
    if (it < 5632) { const int nb = it % 176, kb = it / 176; const int n0 = nb * 64;
        int drow; if (n0 < 5632) drow = n0 < CA0 ? n0 : 2 * CA0 + (n0 - CA0); else { const int m = n0 - 5632; drow = m < CA0 ? CA0 + m : 2 * CA0 + CA1 + (m - CA0); }
        t.src = a.in[37] + (size_t)(kb * 64) * 11264 + n0; t.N = 11264; t.dst = (bf16*)(ws + WS_WUP) + (size_t)drow * 2048 + kb * 64; t.ldk = 2048; }
    else { const int r = it - 5632; const int nb = r & 31, kb = r >> 5; const int k0 = kb * 64;
        t.src = a.in[40] + (size_t)k0 * 2048 + nb * 64; t.N = 2048;
        if (k0 < CA0) { t.dst = (bf16*)(ws + WS_WD0) + (size_t)(nb * 64) * CA0 + k0; t.ldk = CA0; } else { t.dst = (bf16*)(ws + WS_WD1) + (size_t)(nb * 64) * CA1 + (k0 - CA0); t.ldk = CA1; } }
    return t;
}
#define TR_PIPELINE(ITEMFN, NITEMS) do { int it_ = gw; if (it_ < (NITEMS)) { TrItem cur_ = ITEMFN(a, ws, it_); f32x4 v_[16]; tr_load(cur_, v_, lane); \
        for (;;) { tr_lds_write(v_, scr, lane); LDS_FENCE(); const int nx_ = it_ + NGW; const bool hn_ = nx_ < (NITEMS); TrItem nxt_ = cur_; \
            if (hn_) { nxt_ = ITEMFN(a, ws, nx_); tr_load(nxt_, v_, lane); } asm volatile("" ::: "memory"); \
            tr_store(cur_, scr, lane); LDS_FENCE(); if (!hn_) break; cur_ = nxt_; it_ = nx_; } } } while (0)

__global__ void __launch_bounds__(NTHR, 2) fwd_kernel(Args a_) {
    extern __shared__ __attribute__((aligned(16))) unsigned char lds_raw[];
    LAS unsigned char* lds = (LAS unsigned char*)lds_raw;
    const int tid = threadIdx.x, lane = tid & 63, wave = __builtin_amdgcn_readfirstlane(tid >> 6);
    const int G = gridDim.x, bid = blockIdx.x;
    const int gw = bid * NWAVES + wave, NGW = G * NWAVES;
    const int gthr = bid * NTHR + tid, nthr = G * NTHR;
    cg::grid_group grid = cg::this_grid();
    unsigned* barw = (unsigned*)(a_.ws + WS_BAR);
    volatile LAS unsigned* bst = (volatile LAS unsigned*)(lds + LDS_BYTES - 16);
    if (tid < 2) bst[tid] = 0u;
    __syncthreads();
    XcdBarrier xbar = xcd_barrier_post(barw, bst);
    if (a_.ph_lo < 0) grid.sync();
    const int lo = a_.ph_lo, hi = a_.ph_hi;
#define PHASE_ARGS KA a = *kargs(); unsigned char* ws = a.ws; const float* mod = (const float*)(ws + WS_MOD); (void)mod
#ifndef REP_FILT
#define REP_FILT 0
#endif
#ifndef REP_S5
#define REP_S5 0
#endif
#ifndef REP_HY0
#define REP_HY0 0
#endif
#ifndef REP_HY1
#define REP_HY1 0
#endif
#ifndef REP_MASK
#define REP_MASK 0
#endif
#define REPN(k) (((REP_MASK) >> (k)) & 1)
#ifndef PH_MASK
#define PH_MASK 0xffff
#endif
#define IN(k) ((((PH_MASK) >> (k)) & 1) && lo <= (k) && (k) < hi)
#define SEAM(k) do { if (IN(k) && IN((k) + 1)) xcd_barrier(xbar); } while (0)

    if (IN(0)) for (int rep_ = 0; rep_ <= REPN(0); ++rep_) { if (rep_) __syncthreads(); PHASE_ARGS;
        constexpr int N_H3 = 272, N_T = 6400;
        for (int u = bid; u < 192; u += G) mod_block_unit(a, lds, u, tid);
        LAS float* scr = (LAS float*)(lds + wave * 16640);
        if (gw >= NGW - N_H3) h3_unit(a, NGW - 1 - gw, lane);
        TR_PIPELINE(p0_item, N_T);
    }
    SEAM(0);
#ifdef EXTRA_SYNCS
    for (int q_ = 0; q_ < EXTRA_SYNCS; ++q_) grid.sync();
#endif
    if (IN(1)) for (int rep_ = 0; rep_ <= REPN(1); ++rep_) { if (rep_) __syncthreads(); PHASE_ARGS;
        for (int rf_ = 0; rf_ <= REP_FILT; ++rf_)
        for (int it = gw; it < 4352; it += NGW) filt_unit(a, it, lane);
        norm_rows<0, false>(a.in[0], a.in[1], a.in[8], mod + 2048, mod, (bf16*)(ws + WS_A), gw, NGW, lane);
    }
    SEAM(1);
    if (IN(2)) for (int rep_ = 0; rep_ <= REPN(2); ++rep_) { if (rep_) __syncthreads(); PHASE_ARGS;
        { pg8::Gemm g{(const bf16*)(ws + WS_WIN), (const bf16*)(ws + WS_A), 3072, 16384, 2048}; pg8::StaticOrder S; S.init(3072, 16384, G, bid);
          pg8::EpiHyT E{(bf16*)(ws + WS_HYT), a.in[12]};
          pg8::gemm_phase<pg8::EpiHyT, pg8::StaticOrder, true, true>(lds, g, S, E); }
        { pg8::Gemm g{(const bf16*)(ws + WS_A), (const bf16*)(ws + WS_WIN) + (size_t)3072 * 2048, 16384, 5120, 2048}; pg8::StaticOrder S; S.init(16384, 5120, G, bid);
          pg8::EpiRest E{(bf16*)(ws + WS_SSM), (bf16*)(ws + WS_GATES), a.in[12] + 3072};
          pg8::gemm_phase<pg8::EpiRest, pg8::StaticOrder, true, true>(lds, g, S, E); }
    }
    SEAM(2);
    if (IN(3)) for (int rep_ = 0; rep_ <= REPN(3); ++rep_) { if (rep_) __syncthreads(); PHASE_ARGS;
        for (int rs_ = 0; rs_ <= REP_S5; ++rs_)
        for (int it = gw; it < 4096; it += NGW) { const int kind = it < 2048 ? 0 : 1; const int r = it & 2047; const int g = r & 63, dir = (r >> 6) & 1, ps = r >> 7;
            if (kind == 1 && ps == 15) continue;
            if (kind == 0) s5_unit(a, lds + wave * 8704, 0, ps, dir, g, lane); else s5_unit(a, lds + wave * 8704, 1, ps, dir, g, lane); }
        __syncthreads();
        for (int rh_ = 0; rh_ <= REP_HY0; ++rh_)
        { HyIn<0> I; if (bid < 1024) hy_load<0>(a, bid, tid, I);
          for (int c = bid; c < 1024; c += G) hyena_unit<0>(a, lds, c, tid, I, c + G < 1024, c + G); }
    }
    SEAM(3);
    if (IN(4)) for (int rep_ = 0; rep_ <= REPN(4); ++rep_) { if (rep_) __syncthreads(); PHASE_ARGS;
        for (int rs_ = 0; rs_ <= REP_S5; ++rs_)
        for (int it = gw; it < 2048; it += NGW) { const int g = it & 63, dir = (it >> 6) & 1, ps = it >> 7; s5_unit(a, lds + wave * 8704, 2, ps, dir, g, lane); }
        __syncthreads();
        for (int rh_ = 0; rh_ <= REP_HY1; ++rh_)
        { HyIn<1> I; if (bid < 1024) hy_load<1>(a, bid, tid, I);
          for (int c = bid; c < 1024; c += G) hyena_unit<1>(a, lds, c, tid, I, c + G < 1024, c + G); }
    }
    SEAM(4);
    if (IN(5)) for (int rep_ = 0; rep_ <= REPN(5); ++rep_) { if (rep_) __syncthreads(); PHASE_ARGS;
        combine_items(a, gthr, nthr);
        for (int it = gw; it < 4096; it += NGW) yh_transpose_item(a, it, (LAS bf16*)(lds + wave * 8448), lane);
    }
    SEAM(5);
    if (IN(6)) for (int rep_ = 0; rep_ <= REPN(6); ++rep_) { if (rep_) __syncthreads(); PHASE_ARGS;
        pg8::Gemm g{(const bf16*)(ws + WS_G), (const bf16*)(ws + WS_WGLU), 16384, 1024, 1024}; pg8::StaticOrder S; S.init(16384, 1024, G, bid);
        pg8::EpiGate<0> E{(bf16*)(ws + WS_YS), 1024, (const bf16*)(ws + WS_G), 1024, a.in[34]};
        pg8::gemm_phase<pg8::EpiGate<0>, pg8::StaticOrder, true, true>(lds, g, S, E);
    }
    SEAM(6);
    if (IN(7)) for (int rep_ = 0; rep_ <= REPN(7); ++rep_) { if (rep_) __syncthreads(); PHASE_ARGS;
        { pg8::Gemm g{(const bf16*)(ws + WS_YH), (const bf16*)(ws + WS_WBH), 16384, 2048, 1024}; pg8::StaticOrder S; S.init(16384, 2048, G, bid);
          pg8::EpiBr<1> E{(bf16*)(ws + WS_MERGED), (const unsigned char*)(ws + WS_GATES), 0};
          pg8::gemm_phase<pg8::EpiBr<1>, pg8::StaticOrder, true, true>(lds, g, S, E); }
        { pg8::Gemm g{(const bf16*)(ws + WS_YS), (const bf16*)(ws + WS_WBS), 16384, 2048, 1024}; pg8::StaticOrder S; S.init(16384, 2048, G, bid);
          pg8::EpiBr<2> E{(bf16*)(ws + WS_MERGED), (const unsigned char*)(ws + WS_GATES), 2048};
          pg8::gemm_phase<pg8::EpiBr<2>, pg8::StaticOrder, true, true>(lds, g, S, E); }
    }
    SEAM(7);
    if (IN(8)) for (int rep_ = 0; rep_ <= REPN(8); ++rep_) { if (rep_) __syncthreads(); PHASE_ARGS;
        pg8::Gemm g{(const bf16*)(ws + WS_MERGED), (const bf16*)(ws + WS_WOUT), 16384, 2048, 2048}; pg8::StaticOrder S; S.init(16384, 2048, G, bid);
        pg8::EpiRes E{a.in[0], a.in[1], a.out, mod + 2 * 2048};
        pg8::gemm_phase<pg8::EpiRes, pg8::StaticOrder, true, true>(lds, g, S, E);
    }
    SEAM(8);
    if (IN(9)) for (int rep_ = 0; rep_ <= REPN(9); ++rep_) { if (rep_) __syncthreads(); PHASE_ARGS;
        LAS float* scr = (LAS float*)(lds + wave * 16640);
        norm_rows<0, true>(a.out, nullptr, a.in[9], mod + 4 * 2048, mod + 3 * 2048, (bf16*)(ws + WS_A), gw, NGW, lane);
        TR_PIPELINE(p9_item, 5632 + 2816);
    }
    SEAM(9);
    if (IN(10)) for (int rep_ = 0; rep_ <= REPN(10); ++rep_) { if (rep_) __syncthreads(); PHASE_ARGS;
        pg8::Gemm g{(const bf16*)(ws + WS_A), (const bf16*)(ws + WS_WUP), 16384, 2 * CA0, 2048}; pg8::StaticOrder S; S.init(16384, 2 * CA0, G, bid);
        pg8::EpiPlain E{(bf16*)(ws + WS_UP), 2 * CA0};
        pg8::gemm_phase<pg8::EpiPlain, pg8::StaticOrder, true, true>(lds, g, S, E);
    }
    SEAM(10);
    if (IN(11)) for (int rep_ = 0; rep_ <= REPN(11); ++rep_) { if (rep_) __syncthreads(); PHASE_ARGS; (void)ws; conv_items(a, gw, NGW, lane, CA0, 0); }
    SEAM(11);
    if (IN(12)) for (int rep_ = 0; rep_ <= REPN(12); ++rep_) { if (rep_) __syncthreads(); PHASE_ARGS;
        { pg8::Gemm g{(const bf16*)(ws + WS_ACT), (const bf16*)(ws + WS_WD0), 16384, 2048, CA0}; pg8::StaticOrder S; S.init(16384, 2048, G, bid);
          pg8::EpiRes E{nullptr, nullptr, a.out, mod + 5 * 2048};
          pg8::gemm_phase<pg8::EpiRes, pg8::StaticOrder, true, true>(lds, g, S, E); }
        { pg8::Gemm g{(const bf16*)(ws + WS_A), (const bf16*)(ws + WS_WUP) + (size_t)2 * CA0 * 2048, 16384, 2 * CA1, 2048}; pg8::StaticOrder S; S.init(16384, 2 * CA1, G, bid);
          pg8::EpiPlain E{(bf16*)(ws + WS_UP), 2 * CA1};
          pg8::gemm_phase<pg8::EpiPlain, pg8::StaticOrder, true, true>(lds, g, S, E); }
    }
    SEAM(12);
    if (IN(13)) for (int rep_ = 0; rep_ <= REPN(13); ++rep_) { if (rep_) __syncthreads(); PHASE_ARGS; (void)ws; conv_items(a, gw, NGW, lane, CA1, CA0); }
    SEAM(13);
    if (IN(14)) for (int rep_ = 0; rep_ <= REPN(14); ++rep_) { if (rep_) __syncthreads(); PHASE_ARGS;
        pg8::Gemm g{(const bf16*)(ws + WS_ACT), (const bf16*)(ws + WS_WD1), 16384, 2048, CA1}; pg8::StaticOrder S; S.init(16384, 2048, G, bid);
        pg8::EpiRes E{nullptr, nullptr, a.out, mod + 5 * 2048};
        pg8::gemm_phase<pg8::EpiRes, pg8::StaticOrder, true, true>(lds, g, S, E);
    }
    SEAM(14);
    if (IN(15)) for (int rep_ = 0; rep_ <= REPN(15); ++rep_) { if (rep_) __syncthreads(); PHASE_ARGS;
        norm_rows<1, true>(a.out, nullptr, a.in[10], nullptr, nullptr, a.out, gw, NGW, lane);
    }
#undef IN
#undef SEAM
}

#ifndef MK_SINGLE
#define MK_SINGLE 1
#endif
constexpr int N_PHASES = 16;
extern "C" void kernel_launch(void* const* d_in, const int* in_sizes, int n_in, void* d_out, int out_size, void* d_ws, size_t ws_size, hipStream_t stream) {
    static int grid = 0;
    if (grid == 0) {
        if (n_in != 41 || ws_size < WS_END) { fprintf(stderr, "kernel_launch: need 41 inputs and %zu bytes of workspace (got %d, %zu)\n", (size_t)WS_END, n_in, ws_size); grid = -1; return; }
        int dev = 0, cus = 0, per_cu = 0;
        if (hipGetDevice(&dev) != hipSuccess || hipDeviceGetAttribute(&cus, hipDeviceAttributeMultiprocessorCount, dev) != hipSuccess) { grid = -1; return; }
        if (hipFuncSetAttribute((const void*)fwd_kernel, hipFuncAttributeMaxDynamicSharedMemorySize, LDS_BYTES) != hipSuccess) { fprintf(stderr, "kernel_launch: hipFuncSetAttribute failed\n"); grid = -1; return; }
        if (hipOccupancyMaxActiveBlocksPerMultiprocessor(&per_cu, (const void*)fwd_kernel, NTHR, LDS_BYTES) != hipSuccess || per_cu < 1) { fprintf(stderr, "kernel_launch: occupancy query gave %d\n", per_cu); per_cu = 1; }
        (void)hipGetLastError();
        grid = cus * (per_cu < 1 ? 1 : 1);
    }
    if (grid < 0) return;
    (void)hipMemsetAsync((char*)d_ws + WS_BAR, 0, 16384, stream);
    Args a{};
    for (int i = 0; i < 41; ++i) a.in[i] = (const float*)d_in[i];
    a.out = (float*)d_out; a.ws = (unsigned char*)d_ws;
#if MK_SINGLE
    a.ph_lo = 0; a.ph_hi = N_PHASES;
    void* args[] = {&a};
    hipError_t e = hipLaunchCooperativeKernel((const void*)fwd_kernel, dim3(grid), dim3(NTHR), args, LDS_BYTES, stream);
    if (e != hipSuccess) fprintf(stderr, "kernel_launch: cooperative launch failed: %s (grid %d)\n", hipGetErrorString(e), grid);
#else
#ifndef DBG_STOP
#define DBG_STOP N_PHASES
#endif
    for (int ph = 0; ph < DBG_STOP; ++ph) { a.ph_lo = ph; a.ph_hi = ph + 1;
        hipLaunchKernelGGL(fwd_kernel, dim3(grid), dim3(NTHR), LDS_BYTES, stream, a); }
#endif
}
```

```cpp
#include <hip/hip_runtime.h>
#include <hip/hip_cooperative_groups.h>
#include <cstdio>
#include <cstdint>
namespace cg = cooperative_groups;
namespace pg8 {
#define PG8_LAS __attribute__((address_space(3)))
typedef unsigned short bf16_t;
typedef short bf16x8 __attribute__((ext_vector_type(8)));
typedef float f32x4 __attribute__((ext_vector_type(4)));
typedef unsigned u32x4 __attribute__((ext_vector_type(4)));
constexpr int BM = 256, BK = 64, HALF = 128, HTB = HALF * BK * 2  , STAGE_BYTES = 8 * HTB, NXCD = 8, WGM = 8;

__host__ __device__ __forceinline__ int lds_byte(int r, int c) { const int st = (r >> 4) * 2 + (c >> 5), rr = r & 15, cc = c & 31, ob = rr * 64 + cc * 2; return st * 1024 + (ob ^ (((ob >> 9) & 1) << 5)); }
__host__ __device__ __forceinline__ void stage_rc(int b, int& R, int& C) { const int st = b / 1024, sb = b % 1024, swz = sb ^ (((sb >> 9) & 1) << 5); R = (st >> 1) * 16 + swz / 64; C = (st & 1) * 32 + (swz % 64) / 2; }
__host__ __device__ __forceinline__ int perm32(int rho) { const int n = rho >> 4, i = rho & 15; return 8 * (i >> 2) + 4 * n + (i & 3); }

struct Unit { int pm, pn; };
struct Gemm { const bf16_t* A; const bf16_t* Bt; int M, N, K; };

struct StaticOrder {
    int nM, nN, nwg, G, c;
    __host__ __device__ void init(int M, int N, int G_, int c_) { nM = M / BM; nN = N / BM; nwg = nM * nN; G = G_; c = c_; }
    __host__ __device__ bool next(int i, Unit& u) const {
        const long L = (long)i * G + c; if (L >= nwg) return false;
        int wgid = (int)L; { const int q = nwg / NXCD, r = nwg % NXCD, xcd = wgid % NXCD, off = wgid / NXCD; wgid = (xcd < r ? xcd * (q + 1) : r * (q + 1) + (xcd - r) * q) + off; }
        const int nig = WGM * nN, gid = wgid / nig, fm = gid * WGM, gsz = (nM - fm) < WGM ? (nM - fm) : WGM;
        u.pm = fm + ((wgid % nig) % gsz); u.pn = (wgid % nig) / gsz; return true;
    }
    __device__ __forceinline__ void a_ready(const Unit&) const {}
    __device__ __forceinline__ void done(const Unit&) const {}
};

typedef float f32x2c __attribute__((ext_vector_type(2))); typedef __bf16 bf16x2c __attribute__((ext_vector_type(2)));
__device__ __forceinline__ unsigned cvt_pk_bf16(float lo, float hi) { const f32x2c v = {lo, hi}; return __builtin_bit_cast(unsigned, __builtin_convertvector(v, bf16x2c)); }
typedef float f32x2 __attribute__((ext_vector_type(2)));
template <class Epi, class Sched, bool ALIGN_EPI = false, bool SP2 = false>
__device__ __forceinline__ void gemm_phase(PG8_LAS unsigned char* lds, const Gemm g, const Sched& S, const Epi& E) {
    const int tid = threadIdx.x, wid = __builtin_amdgcn_readfirstlane(tid >> 6), lane = tid & 63, wr = wid >> 2, wc = wid & 3, fr = lane & 15, fq = lane >> 4;
    const int K = g.K, nt = K / BK;
    unsigned voffA[2], voffB[2];
#pragma unroll
    for (int i = 0; i < 2; ++i) { int R, C; stage_rc(tid * 16 + i * 8192, R, C); const int Rb = Epi::PERM ? ((R & ~31) + perm32(R & 31)) : R;
        voffA[i] = (unsigned)(R * K + C) * 2u; voffB[i] = (unsigned)(Rb * K + C) * 2u; }
    const size_t kstep = (size_t)(BK * 2);
    const size_t hstep = (size_t)HALF * K * 2;
    const size_t tstep = 2 * hstep;
    const unsigned ldsw = (unsigned)wid * 1024u;
    const int aoff = lds_byte(wr * 64 + fr, fq * 8), boff = lds_byte(wc * 32 + fr, fq * 8);
#define PG8_SA(b, h) (((b) * 2 + (h)) * HTB)
#define PG8_SB(b, h) ((4 + (b) * 2 + (h)) * HTB)
#define PG8_STAGE(bufoff, gbase, voff) do { _Pragma("unroll") for (int _i = 0; _i < 2; ++_i) \
        __builtin_amdgcn_global_load_lds((const unsigned*)((const char*)(gbase) + (voff)[_i]), (PG8_LAS unsigned*)(lds + (bufoff) + ldsw + _i * 8192), 16, 0, 0); } while (0)
#define PG8_LDA(dst, b, h) do { _Pragma("unroll") for (int m = 0; m < 4; ++m) _Pragma("unroll") for (int k = 0; k < 2; ++k) dst[m][k] = *(const PG8_LAS bf16x8*)(lds + PG8_SA(b, h) + aoff + m * 2048 + k * 1024); } while (0)
#define PG8_LDB(dst, b, h) do { _Pragma("unroll") for (int n = 0; n < 2; ++n) _Pragma("unroll") for (int k = 0; k < 2; ++k) dst[n][k] = *(const PG8_LAS bf16x8*)(lds + PG8_SB(b, h) + boff + n * 2048 + k * 1024); } while (0)
#define PG8_MMA(ai, bj, At, Bt) do { __builtin_amdgcn_s_setprio(1); _Pragma("unroll") for (int m = 0; m < 4; ++m) _Pragma("unroll") for (int n = 0; n < 2; ++n) _Pragma("unroll") for (int k = 0; k < 2; ++k) \
        acc[ai][bj][m][n] = __builtin_amdgcn_mfma_f32_16x16x32_bf16(Bt[n][k], At[m][k], acc[ai][bj][m][n], 0, 0, 0); __builtin_amdgcn_s_setprio(0); } while (0)
#define PG8_WAIT_V(n) asm volatile("s_waitcnt vmcnt(" #n ")" ::: "memory")
#define PG8_WAIT_L(n) asm volatile("s_waitcnt lgkmcnt(" #n ")" ::: "memory")
#define PG8_BAR __builtin_amdgcn_s_barrier()
#define PG8_SCHED __builtin_amdgcn_sched_barrier(0)
    Unit cur, nxt; int ui = 0;
    if (!S.next(0, cur)) return;
    f32x4 acc[2][2][4][2];
#pragma unroll
    for (int a = 0; a < 2; ++a)
#pragma unroll
        for (int b = 0; b < 2; ++b)
#pragma unroll
            for (int m = 0; m < 4; ++m)
#pragma unroll
                for (int n = 0; n < 2; ++n) acc[a][b][m][n] = (f32x4){0.f, 0.f, 0.f, 0.f};
    bf16x8 At[4][2], B0[2][2], B1[2][2];
    const char* cA = (const char*)g.A + (size_t)cur.pm * tstep; const char* cB = (const char*)g.Bt + (size_t)cur.pn * tstep;
    S.a_ready(cur);
    if constexpr (SP2) {
        PG8_STAGE(PG8_SB(0, 0), cB, voffB); PG8_STAGE(PG8_SB(0, 1), cB + hstep, voffB); PG8_STAGE(PG8_SA(0, 0), cA, voffA); PG8_STAGE(PG8_SA(0, 1), cA + hstep, voffA);
        if (wr == 1) PG8_BAR;
        PG8_WAIT_V(2); PG8_BAR;
        PG8_STAGE(PG8_SB(1, 0), cB + kstep, voffB); PG8_STAGE(PG8_SA(1, 0), cA + kstep, voffA); PG8_STAGE(PG8_SB(1, 1), cB + hstep + kstep, voffB);
        PG8_WAIT_V(6); PG8_BAR;
    } else {
        PG8_STAGE(PG8_SB(0, 0), cB, voffB); PG8_STAGE(PG8_SA(0, 0), cA, voffA); PG8_STAGE(PG8_SB(0, 1), cB + hstep, voffB); PG8_STAGE(PG8_SA(0, 1), cA + hstep, voffA);
        if (wr == 1) PG8_BAR;
        PG8_WAIT_V(4); PG8_BAR;
        PG8_STAGE(PG8_SB(1, 0), cB + kstep, voffB); PG8_STAGE(PG8_SA(1, 0), cA + kstep, voffA); PG8_STAGE(PG8_SB(1, 1), cB + hstep + kstep, voffB);
        PG8_WAIT_V(6); PG8_BAR;
    }
    for (;;) {
        const bool has_next = S.next(ui + 1, nxt);
        const char* nA = has_next ? (const char*)g.A + (size_t)nxt.pm * tstep : cA; const char* nB = has_next ? (const char*)g.Bt + (size_t)nxt.pn * tstep : cB;
        for (int t = 0; t < nt; t += 2) {
            const bool last = (t == nt - 2);
            const char* a1 = cA + (size_t)(t + 1) * kstep;
            const char* a2 = last ? nA : cA + (size_t)(t + 2) * kstep; const char* b2 = last ? nB : cB + (size_t)(t + 2) * kstep;
            const char* a3 = a2 + kstep; const char* b3 = b2 + kstep;
            if (last && has_next) S.a_ready(nxt);
            if constexpr (SP2) {
            PG8_LDB(B0, 0, 0); PG8_LDB(B1, 0, 1); PG8_SCHED; PG8_LDA(At, 0, 0); PG8_STAGE(PG8_SA(1, 1), a1 + hstep, voffA);
            PG8_WAIT_V(8); PG8_WAIT_L(0); PG8_BAR; PG8_MMA(0, 0, At, B0); PG8_MMA(0, 1, At, B1); PG8_BAR; PG8_SCHED;
            PG8_LDA(At, 0, 1); PG8_STAGE(PG8_SB(0, 0), b2, voffB); PG8_STAGE(PG8_SB(0, 1), b2 + hstep, voffB); PG8_STAGE(PG8_SA(0, 0), a2, voffA);
            PG8_WAIT_V(8); PG8_WAIT_L(0); PG8_BAR; PG8_MMA(1, 0, At, B0); PG8_MMA(1, 1, At, B1); PG8_BAR; PG8_SCHED;
            PG8_LDB(B0, 1, 0); PG8_LDB(B1, 1, 1); PG8_SCHED; PG8_LDA(At, 1, 0); PG8_STAGE(PG8_SA(0, 1), a2 + hstep, voffA);
            PG8_WAIT_V(8); PG8_WAIT_L(0); PG8_BAR; PG8_MMA(0, 0, At, B0); PG8_MMA(0, 1, At, B1); PG8_BAR; PG8_SCHED;
            PG8_LDA(At, 1, 1); PG8_STAGE(PG8_SB(1, 0), b3, voffB); PG8_STAGE(PG8_SB(1, 1), b3 + hstep, voffB); PG8_STAGE(PG8_SA(1, 0), a3, voffA);
            PG8_WAIT_V(8); PG8_WAIT_L(0); PG8_BAR; PG8_MMA(1, 0, At, B0); PG8_MMA(1, 1, At, B1); PG8_BAR; PG8_SCHED;
            } else {
            PG8_LDB(B0, 0, 0); PG8_SCHED; PG8_LDA(At, 0, 0); PG8_STAGE(PG8_SA(1, 1), a1 + hstep, voffA);
            PG8_WAIT_L(8); PG8_BAR; PG8_WAIT_L(0); PG8_MMA(0, 0, At, B0); PG8_BAR; PG8_SCHED;
            PG8_LDB(B1, 0, 1); PG8_STAGE(PG8_SB(0, 0), b2, voffB);
            PG8_BAR; PG8_WAIT_L(0); PG8_MMA(0, 1, At, B1); PG8_BAR;
            PG8_LDA(At, 0, 1); PG8_STAGE(PG8_SA(0, 0), a2, voffA);
            PG8_BAR; PG8_WAIT_L(0); PG8_MMA(1, 0, At, B0); PG8_BAR; PG8_SCHED;
            PG8_STAGE(PG8_SB(0, 1), b2 + hstep, voffB);
            PG8_WAIT_V(6); PG8_BAR; PG8_MMA(1, 1, At, B1); PG8_BAR;
            PG8_LDB(B0, 1, 0); PG8_SCHED; PG8_LDA(At, 1, 0); PG8_STAGE(PG8_SA(0, 1), a2 + hstep, voffA);
            PG8_WAIT_L(8); PG8_BAR; PG8_WAIT_L(0); PG8_MMA(0, 0, At, B0); PG8_BAR; PG8_SCHED;
            PG8_LDB(B1, 1, 1); PG8_STAGE(PG8_SB(1, 0), b3, voffB);
            PG8_BAR; PG8_WAIT_L(0); PG8_MMA(0, 1, At, B1); PG8_BAR;
            PG8_LDA(At, 1, 1); PG8_STAGE(PG8_SA(1, 0), a3, voffA);
            PG8_BAR; PG8_WAIT_L(0); PG8_MMA(1, 0, At, B0); PG8_BAR; PG8_SCHED;
            PG8_STAGE(PG8_SB(1, 1), b3 + hstep, voffB);
            PG8_WAIT_V(6); PG8_BAR; PG8_MMA(1, 1, At, B1); PG8_BAR;
            }
        }
        if constexpr (ALIGN_EPI) { if (wr == 0) PG8_BAR; }
        if constexpr (!Epi::AFTER_DRAIN) { E(acc, cur, wr, wc, fr, fq); S.done(cur); }
        if (!has_next) break;
#pragma unroll
        for (int a = 0; a < 2; ++a)
#pragma unroll
            for (int b = 0; b < 2; ++b)
#pragma unroll
                for (int m = 0; m < 4; ++m)
#pragma unroll
                    for (int n = 0; n < 2; ++n) acc[a][b][m][n] = (f32x4){0.f, 0.f, 0.f, 0.f};
        cur = nxt; cA = nA; cB = nB; ++ui;
        if constexpr (ALIGN_EPI) { if (wr == 1) PG8_BAR; }
    }
    PG8_WAIT_V(0);
    if constexpr (!ALIGN_EPI) { if (wr == 0) PG8_BAR; }
    PG8_BAR;
    if constexpr (Epi::AFTER_DRAIN) { E.fused(acc, cur, wr, wc, fr, fq, lds, wid, lane); S.done(cur); }
#undef PG8_SA
#undef PG8_SB
#undef PG8_STAGE
#undef PG8_LDA
#undef PG8_LDB
#undef PG8_MMA
#undef PG8_WAIT_V
#undef PG8_WAIT_L
#undef PG8_BAR
#undef PG8_SCHED
}
}

namespace pg8 {
typedef unsigned u32x4 __attribute__((ext_vector_type(4)));
__device__ __forceinline__ float bflo(unsigned w) { return __uint_as_float(w << 16); }
__device__ __forceinline__ float bfhi(unsigned w) { return __uint_as_float(w & 0xffff0000u); }
__device__ __forceinline__ float sigm(float x) { return 1.0f / (1.0f + __expf(-x)); }
__device__ __forceinline__ u32x4 pack8(const f32x4 a, const f32x4 b) { u32x4 w; w.x = cvt_pk_bf16(a[0], a[1]); w.y = cvt_pk_bf16(a[2], a[3]); w.z = cvt_pk_bf16(b[0], b[1]); w.w = cvt_pk_bf16(b[2], b[3]); return w; }
__device__ __forceinline__ void unpack8(const u32x4 w, f32x4& a, f32x4& b) { a = (f32x4){bflo(w.x), bfhi(w.x), bflo(w.y), bfhi(w.y)}; b = (f32x4){bflo(w.z), bfhi(w.z), bflo(w.w), bfhi(w.w)}; }

struct EpiHyT {
    static constexpr bool PERM = true, AFTER_DRAIN = false;
    bf16_t* O; const float* bias;
    __device__ __forceinline__ void operator()(const f32x4 (&acc)[2][2][4][2], const Unit& u, int wr, int wc, int fr, int fq) const {
        const int row0 = u.pm * BM + wr * 64 + fr, col0 = u.pn * BM + wc * 32 + 8 * fq;
#pragma unroll
        for (int ai = 0; ai < 2; ++ai)
#pragma unroll
            for (int m = 0; m < 4; ++m) { const int row = row0 + ai * HALF + m * 16; const float bv = bias[row]; bf16_t* rowp = O + (size_t)row * 16384 + col0;
#pragma unroll
                for (int bj = 0; bj < 2; ++bj) { const f32x4 v0 = acc[ai][bj][m][0] + bv, v1 = acc[ai][bj][m][1] + bv; *(u32x4*)(rowp + bj * HALF) = pack8(v0, v1); } }
    }
};
struct EpiRest {
    static constexpr bool PERM = true, AFTER_DRAIN = false;
    bf16_t* Ossm; bf16_t* Ogates; const float* bias;
    __device__ __forceinline__ void operator()(const f32x4 (&acc)[2][2][4][2], const Unit& u, int wr, int wc, int fr, int fq) const {
        const int row0 = u.pm * BM + wr * 64 + fr; const int colt = u.pn * BM;
        bf16_t* base; int ldc, cb;
        if (u.pn < 4) { base = Ossm; ldc = 1024; cb = colt; } else { base = Ogates; ldc = 4096; cb = colt - 1024; }
        const int col0 = cb + wc * 32 + 8 * fq, bcol0 = colt + wc * 32 + 8 * fq;
        f32x4 bv[2][2];
#pragma unroll
        for (int bj = 0; bj < 2; ++bj)
#pragma unroll
            for (int n = 0; n < 2; ++n) bv[bj][n] = *(const f32x4*)(bias + bcol0 + bj * HALF + 4 * n);
#pragma unroll
        for (int ai = 0; ai < 2; ++ai)
#pragma unroll
            for (int m = 0; m < 4; ++m) { bf16_t* rowp = base + (size_t)(row0 + ai * HALF + m * 16) * ldc + col0;
#pragma unroll
                for (int bj = 0; bj < 2; ++bj) { const f32x4 v0 = acc[ai][bj][m][0] + bv[bj][0], v1 = acc[ai][bj][m][1] + bv[bj][1];
                    if (u.pn < 4) *(u32x4*)(rowp + bj * HALF) = pack8(v0, v1);
                    else {
                        typedef unsigned u32x2 __attribute__((ext_vector_type(2)));
                        unsigned q[8];
#pragma unroll
                        for (int e = 0; e < 4; ++e) { q[e] = (unsigned)(sigm(v0[e]) * 255.0f + 0.5f); q[4 + e] = (unsigned)(sigm(v1[e]) * 255.0f + 0.5f); }
                        u32x2 w; w.x = q[0] | (q[1] << 8) | (q[2] << 16) | (q[3] << 24); w.y = q[4] | (q[5] << 8) | (q[6] << 16) | (q[7] << 24);
                        *(u32x2*)((unsigned char*)Ogates + (size_t)(row0 + ai * HALF + m * 16) * 4096 + col0 + bj * HALF) = w; } } }
    }
};
template <int MODE> struct EpiBr {
    static constexpr bool PERM = true, AFTER_DRAIN = false;
    bf16_t* O; const unsigned char* G; int goff;
    __device__ __forceinline__ void operator()(const f32x4 (&acc)[2][2][4][2], const Unit& u, int wr, int wc, int fr, int fq) const {
        typedef unsigned u32x2 __attribute__((ext_vector_type(2)));
        const int row0 = u.pm * BM + wr * 64 + fr, col0 = u.pn * BM + wc * 32 + 8 * fq;
#pragma unroll
        for (int ai = 0; ai < 2; ++ai)
#pragma unroll
            for (int m = 0; m < 4; ++m) { const size_t row = (size_t)(row0 + ai * HALF + m * 16);
#pragma unroll
                for (int bj = 0; bj < 2; ++bj) {
                    const u32x2 gw = *(const u32x2*)(G + row * 4096 + goff + col0 + bj * HALF);
                    f32x4 o0, o1;
#pragma unroll
                    for (int e = 0; e < 4; ++e) { o0[e] = (float)((gw.x >> (8 * e)) & 255u) * (1.0f / 255.0f) * acc[ai][bj][m][0][e]; o1[e] = (float)((gw.y >> (8 * e)) & 255u) * (1.0f / 255.0f) * acc[ai][bj][m][1][e]; }
                    bf16_t* op = O + row * 2048 + col0 + bj * HALF;
                    if (MODE == 2) { const u32x4 pw = *(const u32x4*)op; f32x4 p0, p1; unpack8(pw, p0, p1); o0 += p0; o1 += p1; }
                    *(u32x4*)op = pack8(o0, o1); } }
    }
};
struct EpiPlain {
    static constexpr bool PERM = true, AFTER_DRAIN = false;
    bf16_t* O; int ldc;
    __device__ __forceinline__ void operator()(const f32x4 (&acc)[2][2][4][2], const Unit& u, int wr, int wc, int fr, int fq) const {
        const int row0 = u.pm * BM + wr * 64 + fr, col0 = u.pn * BM + wc * 32 + 8 * fq;
#pragma unroll
        for (int ai = 0; ai < 2; ++ai)
#pragma unroll
            for (int m = 0; m < 4; ++m) { bf16_t* rowp = O + (size_t)(row0 + ai * HALF + m * 16) * ldc + col0;
#pragma unroll
                for (int bj = 0; bj < 2; ++bj) *(u32x4*)(rowp + bj * HALF) = pack8(acc[ai][bj][m][0], acc[ai][bj][m][1]); }
    }
};
template <int MODE> struct EpiGate {
    static constexpr bool PERM = true, AFTER_DRAIN = false;
    bf16_t* O; int ldc; const bf16_t* G; int ldg; const float* bias;
    __device__ __forceinline__ void operator()(const f32x4 (&acc)[2][2][4][2], const Unit& u, int wr, int wc, int fr, int fq) const {
        const int row0 = u.pm * BM + wr * 64 + fr, col0 = u.pn * BM + wc * 32 + 8 * fq;
        f32x4 bv[2][2];
#pragma unroll
        for (int bj = 0; bj < 2; ++bj)
#pragma unroll
            for (int n = 0; n < 2; ++n) bv[bj][n] = (MODE == 0) ? *(const f32x4*)(bias + col0 + bj * HALF + 4 * n) : (f32x4){0.f, 0.f, 0.f, 0.f};
#pragma unroll
        for (int ai = 0; ai < 2; ++ai)
#pragma unroll
            for (int m = 0; m < 4; ++m) { const size_t row = (size_t)(row0 + ai * HALF + m * 16);
#pragma unroll
                for (int bj = 0; bj < 2; ++bj) {
                    const u32x4 gw = *(const u32x4*)(G + row * ldg + col0 + bj * HALF); f32x4 g0, g1; unpack8(gw, g0, g1);
                    f32x4 v0 = acc[ai][bj][m][0] + bv[bj][0], v1 = acc[ai][bj][m][1] + bv[bj][1], o0, o1;
                    bf16_t* op = O + row * ldc + col0 + bj * HALF;
                    if (MODE == 0) {
#pragma unroll
                        for (int e = 0; e < 4; ++e) { o0[e] = g0[e] * sigm(v0[e]); o1[e] = g1[e] * sigm(v1[e]); }
                    } else {
#pragma unroll
                        for (int e = 0; e < 4; ++e) { o0[e] = sigm(g0[e]) * v0[e]; o1[e] = sigm(g1[e]) * v1[e]; }
                        if (MODE == 2) { const u32x4 pw = *(const u32x4*)op; f32x4 p0, p1; unpack8(pw, p0, p1); o0 += p0; o1 += p1; }
                    }
                    *(u32x4*)op = pack8(o0, o1); } }
    }
};
struct EpiRes {
    static constexpr bool PERM = false, AFTER_DRAIN = false;
    const float* xp; const float* xs; float* out; const float* gate;
    __device__ __forceinline__ void operator()(const f32x4 (&acc)[2][2][4][2], const Unit& u, int wr, int wc, int fr, int fq) const {
        typedef unsigned u32x2 __attribute__((ext_vector_type(2)));
        const int col0 = u.pn * BM + wc * 32 + 4 * fq;
#pragma unroll
        for (int ai = 0; ai < 2; ++ai)
#pragma unroll
            for (int m = 0; m < 4; ++m) { const int r = u.pm * BM + ai * HALF + wr * 64 + m * 16 + fr; const size_t off = (size_t)r * 2048 + col0;
                const int type = r < 8192 ? 0 : 1 + ((r - 8192) >> 12);
                const float* bp = r < 8192 ? xp + off : xs + (off - (size_t)8192 * 2048);
                bf16_t* ob = (bf16_t*)out + (size_t)r * 4096 + col0;
                const float* gp = gate + type * 12288 + col0;
#pragma unroll
                for (int bj = 0; bj < 2; ++bj)
#pragma unroll
                    for (int n = 0; n < 2; ++n) { f32x4 bs;
                        if (xp) bs = *(const f32x4*)(bp + bj * HALF + n * 16);
                        else { const u32x2 w = *(const u32x2*)(ob + bj * HALF + n * 16); bs = (f32x4){bflo(w.x), bfhi(w.x), bflo(w.y), bfhi(w.y)}; }
                        const f32x4 gv = *(const f32x4*)(gp + bj * HALF + n * 16);
                        const f32x4 o = bs + gv * acc[ai][bj][m][n];
                        u32x2 ow; ow.x = cvt_pk_bf16(o[0], o[1]); ow.y = cvt_pk_bf16(o[2], o[3]);
                        *(u32x2*)(ob + bj * HALF + n * 16) = ow; } }
    }
};
}

#define LAS __attribute__((address_space(3)))
typedef unsigned short bf16;
typedef unsigned v4u __attribute__((ext_vector_type(4)));
typedef unsigned v2u __attribute__((ext_vector_type(2)));
typedef float f32x4 __attribute__((ext_vector_type(4)));
typedef float f32x16 __attribute__((ext_vector_type(16)));
typedef short bf16x8 __attribute__((ext_vector_type(8)));
typedef short bf16x4 __attribute__((ext_vector_type(4)));

constexpr int NWAVES = 8, NTHR = 512, LDS_BYTES = 147456;
constexpr size_t MiB = 1u << 20;
constexpr size_t WS_MOD = 0, ZERO_BYTES = 256 * 1024;
constexpr size_t WS_BAR = 192 * 1024;
constexpr size_t WS_H3 = 1 * MiB, WS_PART = 3 * MiB, WS_SLOC = 5 * MiB;
constexpr size_t WS_WIN = 16 * MiB, WS_WGLU = 48 * MiB, WS_WBH = 50 * MiB, WS_WBS = 54 * MiB, WS_WOUT = 58 * MiB;
constexpr size_t WS_FILT1 = 66 * MiB, WS_FILT0 = 98 * MiB;
constexpr size_t WS_HYT = 100 * MiB, WS_SSM = 196 * MiB, WS_GATES = 228 * MiB, WS_G = 356 * MiB, WS_A = 392 * MiB, WS_END = 456 * MiB;
constexpr size_t WS_YHT = 16 * MiB;
constexpr size_t WS_YH = 66 * MiB, WS_YS = WS_SSM, WS_MERGED = WS_HYT;
constexpr size_t WS_WUP = 16 * MiB, WS_WD0 = 60 * MiB, WS_WD1 = 70 * MiB, WS_UP = 82 * MiB, WS_ACT = 274 * MiB;
constexpr int CA0 = 2560, CA1 = 3072;

struct Args { const float* in[41]; float* out; unsigned char* ws; int ph_lo, ph_hi; };
#define KA const __attribute__((address_space(4))) Args&
__device__ __forceinline__ const __attribute__((address_space(4))) Args* kargs() { auto p = __builtin_amdgcn_kernarg_segment_ptr(); asm volatile("" : "+s"(p)); return (const __attribute__((address_space(4))) Args*)p; }

__device__ __forceinline__ unsigned pkbf(float lo, float hi) { return pg8::cvt_pk_bf16(lo, hi); }
__device__ __forceinline__ float bf2f(bf16 b) { return __uint_as_float((unsigned)b << 16); }
__device__ __forceinline__ bf16 f2bf(float f) { return (bf16)(pkbf(f, 0.f) & 0xffffu); }
__device__ __forceinline__ float rdlane(float v, int l);
__device__ __forceinline__ float wave_sum(float v) {
    v += __int_as_float(__builtin_amdgcn_update_dpp(0, __float_as_int(v), 0xB1, 0xf, 0xf, false));
    v += __int_as_float(__builtin_amdgcn_update_dpp(0, __float_as_int(v), 0x4E, 0xf, 0xf, false));
    v += __int_as_float(__builtin_amdgcn_update_dpp(0, __float_as_int(v), 0x141, 0xf, 0xf, false));
    v += __int_as_float(__builtin_amdgcn_update_dpp(0, __float_as_int(v), 0x140, 0xf, 0xf, false));
    const float t0 = __int_as_float(__builtin_amdgcn_readlane(__float_as_int(v), 0)), t1 = __int_as_float(__builtin_amdgcn_readlane(__float_as_int(v), 16));
    const float t2 = __int_as_float(__builtin_amdgcn_readlane(__float_as_int(v), 32)), t3 = __int_as_float(__builtin_amdgcn_readlane(__float_as_int(v), 48));
    return (t0 + t1) + (t2 + t3);
}
__device__ __forceinline__ float rdlane(float v, int l) { return __int_as_float(__builtin_amdgcn_readlane(__float_as_int(v), l)); }
__device__ __forceinline__ float silu_f(float x) { return x / (1.0f + __expf(-x)); }
__device__ __forceinline__ float gelu_tanh(float x) { const float u = 0.7978845608028654f * (x + 0.044715f * x * x * x); const float t = 1.0f - 2.0f / (__expf(2.0f * u) + 1.0f); return 0.5f * x * (1.0f + t); }
#define LDS_FENCE() asm volatile("s_waitcnt lgkmcnt(0)" ::: "memory")

__device__ __forceinline__ void transpose_item(const float* W, int N, bf16* WT, int ldk, int dst_row0, int dst_k0, int k0, int n0, LAS float* scr, int lane) {
    const int rs = lane >> 4, c4 = lane & 15;
    f32x4 v[16];
#pragma unroll
    for (int i = 0; i < 16; ++i) v[i] = *(const f32x4*)(W + (size_t)(k0 + 4 * i + rs) * N + n0 + 4 * c4);
#pragma unroll
    for (int i = 0; i < 16; ++i) { LAS float* d = scr + (4 * i + rs) * 65 + 4 * c4; d[0] = v[i].x; d[1] = v[i].y; d[2] = v[i].z; d[3] = v[i].w; }
    LDS_FENCE();
    const int c = lane & 7, ns = lane >> 3;
#pragma unroll
    for (int j = 0; j < 8; ++j) { const int n = ns + 8 * j; const LAS float* s = scr + (8 * c) * 65 + n;
        v4u o; o.x = pkbf(s[0 * 65], s[1 * 65]); o.y = pkbf(s[2 * 65], s[3 * 65]); o.z = pkbf(s[4 * 65], s[5 * 65]); o.w = pkbf(s[6 * 65], s[7 * 65]);
        *(v4u*)(WT + (size_t)(dst_row0 + n) * ldk + dst_k0 + 8 * c) = o; }
    LDS_FENCE();
}

template <int MODE> __device__ __forceinline__ void norm_row(const float* xrow, const float* g, const float* sc, const float* sh, void* orow, int lane) {
    const f32x4* xr = (const f32x4*)xrow + lane;
    f32x4 v[8]; float s = 0.f;
#pragma unroll
    for (int j = 0; j < 8; ++j) { v[j] = xr[64 * j]; s += (v[j].x * v[j].x + v[j].y * v[j].y) + (v[j].z * v[j].z + v[j].w * v[j].w); }
    const float rstd = 1.0f / sqrtf(wave_sum(s) * (1.0f / 2048.0f) + 1e-6f);
#pragma unroll
    for (int j = 0; j < 8; ++j) { const int col = 4 * lane + 256 * j; const f32x4 gv = *(const f32x4*)(g + col); f32x4 y = v[j] * rstd * gv;
        if (MODE == 0) { const f32x4 scv = *(const f32x4*)(sc + col), shv = *(const f32x4*)(sh + col); y = y * (scv + 1.0f) + shv;
            v2u o; o.x = pkbf(y.x, y.y); o.y = pkbf(y.z, y.w); *(v2u*)((bf16*)orow + col) = o; }
        else *(f32x4*)((float*)orow + col) = y; }
}

template <int MODE, bool XBF> __device__ __forceinline__ void norm_rows(const float* x0, const float* x1  , const float* g, const float* modsc, const float* modsh, void* out, int gw, int NGW, int lane) {
    f32x4 A[8], B[8]; int cur = -1;
#define NR_LOAD(dst, rr) do { const int r_ = (rr); const float* xrow_ = (x1 && r_ >= 8192) ? x1 + (size_t)(r_ - 8192) * 2048 : x0 + (size_t)r_ * 2048; \
        const f32x4* xr_ = (const f32x4*)xrow_ + lane; const v2u* xb_ = (const v2u*)((const bf16*)x0 + (size_t)r_ * 4096) + lane; \
        _Pragma("unroll") for (int j = 0; j < 8; ++j) { if (XBF) { const v2u w = xb_[64 * j]; dst[j] = (f32x4){pg8::bflo(w.x), pg8::bfhi(w.x), pg8::bflo(w.y), pg8::bfhi(w.y)}; } else dst[j] = xr_[64 * j]; } } while (0)
    f32x4 v[8], vn[8];
    if (gw < 16384) NR_LOAD(v, gw);
    for (int r = gw; r < 16384; r += NGW) {
        const int type = MODE == 0 ? (r < 8192 ? 0 : 1 + ((r - 8192) >> 12)) : 0;
        if (type != cur) { cur = type;
#pragma unroll
            for (int j = 0; j < 8; ++j) { const int col = 4 * lane + 256 * j; const f32x4 gv = *(const f32x4*)(g + col);
                if (MODE == 0) { A[j] = gv * (*(const f32x4*)(modsc + type * 12288 + col) + 1.0f); B[j] = *(const f32x4*)(modsh + type * 12288 + col); } else { A[j] = gv; B[j] = (f32x4){0.f, 0.f, 0.f, 0.f}; } } }
        const bool hn = r + NGW < 16384;
        if (hn) NR_LOAD(vn, r + NGW);
        asm volatile("" ::: "memory");
        float s = 0.f;
#pragma unroll
        for (int j = 0; j < 8; ++j) s += (v[j].x * v[j].x + v[j].y * v[j].y) + (v[j].z * v[j].z + v[j].w * v[j].w);
        const float rstd = 1.0f / sqrtf(wave_sum(s) * (1.0f / 2048.0f) + 1e-6f);
#pragma unroll
        for (int j = 0; j < 8; ++j) { const int col = 4 * lane + 256 * j;
            if (MODE == 0) { const f32x4 y = (v[j] * rstd) * A[j] + B[j]; v2u o; o.x = pkbf(y.x, y.y); o.y = pkbf(y.z, y.w); *(v2u*)((bf16*)out + (size_t)r * 2048 + col) = o; }
            else *(f32x4*)((float*)out + (size_t)r * 2048 + col) = (v[j] * rstd) * A[j]; }
        if (hn) {
#pragma unroll
            for (int j = 0; j < 8; ++j) v[j] = vn[j]; }
    }
#undef NR_LOAD
}

__device__ __forceinline__ void mod_block_unit(KA a, LAS unsigned char* lds, int u, int tid) {
    const int lane = tid & 63, wave = __builtin_amdgcn_readfirstlane(tid >> 6);
    LAS float* sv = (LAS float*)lds;
    LAS float* red = (LAS float*)(lds + 24576);
    float* mod = (float*)(a.ws + WS_MOD);
    for (int i = tid; i < 2048; i += NTHR) { sv[i] = silu_f(a.in[5][i]); sv[2048 + i] = silu_f(a.in[4][i]); sv[4096 + i] = silu_f(a.in[4][2048 + i]); }
    __syncthreads();
    const int rsub = lane >> 4, c4 = lane & 15;
    const float* wp = a.in[6] + u * 64 + 4 * c4;
    f32x4 a0 = {0.f, 0.f, 0.f, 0.f}, a1 = a0, a2 = a0;
#pragma unroll 8
    for (int i = 0; i < 64; ++i) { const int row = 256 * wave + 4 * i + rsub; const f32x4 w = *(const f32x4*)(wp + (size_t)row * 12288);
        a0 += w * sv[row]; a1 += w * sv[2048 + row]; a2 += w * sv[4096 + row]; }
#pragma unroll
    for (int e = 0; e < 4; ++e) { a0[e] += __shfl_xor(a0[e], 16); a0[e] += __shfl_xor(a0[e], 32); a1[e] += __shfl_xor(a1[e], 16); a1[e] += __shfl_xor(a1[e], 32); a2[e] += __shfl_xor(a2[e], 16); a2[e] += __shfl_xor(a2[e], 32); }
    if (lane < 16) {
#pragma unroll
        for (int e = 0; e < 4; ++e) { red[(wave * 3 + 0) * 64 + 4 * c4 + e] = a0[e]; red[(wave * 3 + 1) * 64 + 4 * c4 + e] = a1[e]; red[(wave * 3 + 2) * 64 + 4 * c4 + e] = a2[e]; } }
    __syncthreads();
    if (tid < 192) { const int type = tid >> 6, cc = tid & 63; float s = a.in[7][u * 64 + cc];
#pragma unroll
        for (int w = 0; w < 8; ++w) s += red[(w * 3 + type) * 64 + cc];
        mod[type * 12288 + u * 64 + cc] = s; }
    __syncthreads();
}
__device__ __forceinline__ void h3_unit(KA a, int u, int lane) {
    const float* w1 = a.in[15]; const float* w2 = a.in[17]; const float* w3 = a.in[19];
    const float fq = a.in[22][lane], b1 = a.in[16][lane], b2 = a.in[18][lane], b3 = a.in[20][lane];
    float* h3 = (float*)(a.ws + WS_H3);
    for (int q = 0; q < 16; ++q) {
        const int pg = u * 16 + q; const int L = pg < 256 ? 256 : 4096; const int pos = pg < 256 ? pg : pg - 256;
        const float t = (float)pos / (float)(L - 1);
        float z = 0.f;
        if (lane == 0) z = t;
        else if (lane <= 32) { const int m = (lane - 1) & 15; const float fr = 1e-4f + (float)m * ((15.0f - 1e-4f) / 15.0f);
            const float ang = ((float)(6.283185307179586 / (double)L) * (float)pos) * fr; z = lane <= 16 ? cosf(ang) : -sinf(ang); }
        float s = 0.f;
#pragma unroll
        for (int k = 0; k < 33; ++k) s += rdlane(z, k) * w1[k * 64 + lane];
        const float h1 = sinf(fq * (s + b1));
        s = 0.f;
#pragma unroll 16
        for (int k = 0; k < 64; ++k) s += rdlane(h1, k) * w2[k * 64 + lane];
        const float h2 = sinf(fq * (s + b2));
        s = 0.f;
#pragma unroll 16
        for (int k = 0; k < 64; ++k) s += rdlane(h2, k) * w3[k * 64 + lane];
        h3[(size_t)pg * 64 + lane] = sinf(fq * (s + b3));
    }
}
__device__ __forceinline__ void split8(const f32x4 p, const f32x4 q, bf16x8& hi, bf16x8& lo) {
    const unsigned h0 = pkbf(p.x, p.y), h1 = pkbf(p.z, p.w), h2 = pkbf(q.x, q.y), h3 = pkbf(q.z, q.w);
    const unsigned l0 = pkbf(p.x - pg8::bflo(h0), p.y - pg8::bfhi(h0)), l1 = pkbf(p.z - pg8::bflo(h1), p.w - pg8::bfhi(h1));
    const unsigned l2 = pkbf(q.x - pg8::bflo(h2), q.y - pg8::bfhi(h2)), l3 = pkbf(q.z - pg8::bflo(h3), q.w - pg8::bfhi(h3));
    const v4u hv = {h0, h1, h2, h3}, lv = {l0, l1, l2, l3};
    hi = __builtin_bit_cast(bf16x8, hv); lo = __builtin_bit_cast(bf16x8, lv);
}
__device__ __forceinline__ void filt_unit(KA a, int fu, int lane) {
    const int set = fu < 4096 ? 1 : 0; const int f = set ? fu : fu - 4096;
    const int pb = set ? ((f >> 9) << 3) + (f & 7) : (f & 3), cb = set ? (f >> 3) & 63 : f >> 2;
    const int L = set ? 4096 : 256;
    const int n = lane & 31, kg = lane >> 5;
    const float* w4 = a.in[21];
    const float* h3 = (const float*)(a.ws + WS_H3) + (size_t)((set ? 256 : 0) + pb * 64) * 64;
    bf16x8 Bhi[2][4], Blo[2][4];
#pragma unroll
    for (int nt = 0; nt < 2; ++nt)
#pragma unroll
        for (int ks = 0; ks < 4; ++ks) { const float* q = h3 + (size_t)(32 * nt + n) * 64 + 16 * ks + 8 * kg;
            split8(*(const f32x4*)q, *(const f32x4*)(q + 4), Bhi[nt][ks], Blo[nt][ks]); }
    f32x16 acc[2][2];
#pragma unroll
    for (int mt = 0; mt < 2; ++mt)
#pragma unroll
        for (int nt = 0; nt < 2; ++nt)
#pragma unroll
            for (int q = 0; q < 16; ++q) acc[mt][nt][q] = 0.f;
#pragma unroll
    for (int mt = 0; mt < 2; ++mt)
#pragma unroll
        for (int ks = 0; ks < 4; ++ks) { const float* q = w4 + (size_t)(16 * ks + 8 * kg) * 4096 + cb * 64 + 32 * mt + n;
            const f32x4 p0 = {q[0], q[4096], q[2 * 4096], q[3 * 4096]}, p1 = {q[4 * 4096], q[5 * 4096], q[6 * 4096], q[7 * 4096]};
            bf16x8 Ahi, Alo; split8(p0, p1, Ahi, Alo);
#pragma unroll
            for (int nt = 0; nt < 2; ++nt) {
                acc[mt][nt] = __builtin_amdgcn_mfma_f32_32x32x16_bf16(Alo, Bhi[nt][ks], acc[mt][nt], 0, 0, 0);
                acc[mt][nt] = __builtin_amdgcn_mfma_f32_32x32x16_bf16(Ahi, Blo[nt][ks], acc[mt][nt], 0, 0, 0);
                acc[mt][nt] = __builtin_amdgcn_mfma_f32_32x32x16_bf16(Ahi, Bhi[nt][ks], acc[mt][nt], 0, 0, 0); } }
    bf16* R = (bf16*)(a.ws + (set ? WS_FILT1 : WS_FILT0));
    float* part = (float*)(a.ws + WS_PART) + (set ? 4 * 4096 : 0) + pb * 4096;
    const float tstep = 1.0f / (float)(L - 1);
#pragma unroll
    for (int mt = 0; mt < 2; ++mt)
#pragma unroll
        for (int reg = 0; reg < 16; ++reg) {
            const int col = cb * 64 + 32 * mt + (reg & 3) + 8 * (reg >> 2) + 4 * kg; const int o = col >> 11, dir = (col >> 10) & 1, c = col & 1023;
            const float delta = fabsf(-3.0701134573253945f + (float)c * ((-15.350567286626973f + 3.0701134573253945f) / 1023.0f));
            bf16* Rrow = R + (size_t)(o * 1024 + c) * (2 * L);
            float asum = 0.f;
#pragma unroll
            for (int nt = 0; nt < 2; ++nt) { const int pos = pb * 64 + 32 * nt + n;
                float kv = acc[mt][nt][reg] * __expf(-((float)pos * tstep) * delta);
                const bool skip = (dir == 1 && pos == 0);
                if (skip) kv = 0.f;
                const int x = skip ? 2 * L - 1 : (dir ? L - 1 + pos : L - 1 - pos);
                Rrow[x] = f2bf(kv); asum += fabsf(kv); }
            asum += __int_as_float(__builtin_amdgcn_update_dpp(0, __float_as_int(asum), 0xB1, 0xf, 0xf, false));
            asum += __int_as_float(__builtin_amdgcn_update_dpp(0, __float_as_int(asum), 0x4E, 0xf, 0xf, false));
            asum += __int_as_float(__builtin_amdgcn_update_dpp(0, __float_as_int(asum), 0x141, 0xf, 0xf, false));
            asum += __int_as_float(__builtin_amdgcn_update_dpp(0, __float_as_int(asum), 0x140, 0xf, 0xf, false));
            const float s0 = rdlane(asum, 0) + rdlane(asum, 16), s1 = rdlane(asum, 32) + rdlane(asum, 48);
            if (lane == 0) { part[col] = s0; part[col + 4] = s1; }
        }
}

__device__ __forceinline__ void s5_unit(KA a, LAS unsigned char* wl, int kind, int ps, int dir, int g, int lane) {
    const int p0 = lane & 31, h = lane >> 5;
    const bf16* ssm = (const bf16*)(a.ws + WS_SSM);
    bf16* ypart = (bf16*)(a.ws + WS_A) + (size_t)dir * 16384 * 1024;
    float* sloc = (float*)(a.ws + WS_SLOC);
    const float dt = __expf(a.in[27][dir * 64 + g]);
    float lr[2], li[2], sr[2], si[2];
    bf16x8 Bf[2][2];
#pragma unroll
    for (int e = 0; e < 2; ++e) { const int pp = p0 + 32 * e; const int idx = (dir * 64 + g) * 64 + pp;
        const float are = fminf(a.in[25][idx], -1e-4f), aim = a.in[26][idx];
        const float mag = __expf(are * dt); lr[e] = mag * cosf(aim * dt); li[e] = mag * sinf(aim * dt);
        const float den = 1.0f / (are * are + aim * aim);
        const float qre = ((lr[e] - 1.0f) * are + li[e] * aim) * den, qim = (li[e] * are - (lr[e] - 1.0f) * aim) * den;
        const f32x4 br0 = *(const f32x4*)(a.in[28] + (size_t)idx * 16 + 8 * h), br1 = *(const f32x4*)(a.in[28] + (size_t)idx * 16 + 8 * h + 4);
        const f32x4 bi0 = *(const f32x4*)(a.in[29] + (size_t)idx * 16 + 8 * h), bi1 = *(const f32x4*)(a.in[29] + (size_t)idx * 16 + 8 * h + 4);
        const f32x4 re0 = br0 * qre - bi0 * qim, re1 = br1 * qre - bi1 * qim, im0 = bi0 * qre + br0 * qim, im1 = bi1 * qre + br1 * qim;
        const v4u wr_ = {pkbf(re0.x, re0.y), pkbf(re0.z, re0.w), pkbf(re1.x, re1.y), pkbf(re1.z, re1.w)};
        const v4u wi_ = {pkbf(im0.x, im0.y), pkbf(im0.z, im0.w), pkbf(im1.x, im1.y), pkbf(im1.z, im1.w)};
        Bf[0][e] = __builtin_bit_cast(bf16x8, wr_); Bf[1][e] = __builtin_bit_cast(bf16x8, wi_);
        sr[e] = 0.f; si[e] = 0.f; }
    bf16x8 Cf[4];
    if (kind != 1) {
        const int ci = lane & 15, kq = lane >> 4;
#pragma unroll
        for (int ks = 0; ks < 4; ++ks) { const size_t o = (size_t)((dir * 64 + g) * 16 + ci) * 64 + 16 * ks + 4 * kq;
            const f32x4 cr = *(const f32x4*)(a.in[30] + o), cm = *(const f32x4*)(a.in[31] + o);
            const v4u w = {pkbf(cr.x, -cm.x), pkbf(cr.y, -cm.y), pkbf(cr.z, -cm.z), pkbf(cr.w, -cm.w)};
            Cf[ks] = __builtin_bit_cast(bf16x8, w); }
    }
    int base0, Lq, segoff;
    if (kind == 0) { base0 = 2 * ps * 256; Lq = 256; segoff = 0; } else { base0 = 8192; Lq = 4096; segoff = 256 * ps; }
    const int seqstride = kind == 0 ? 256 : 4096;
    if (kind == 2) {
#pragma unroll
        for (int e = 0; e < 2; ++e) { const int pp = p0 + 32 * e; const int sidx = ((h * 2 + dir) * 64 + g) * 64 + pp;
            float xr = a.in[2][sidx], xi = a.in[3][sidx];
            float pr = lr[e], pi = li[e];
#pragma unroll
            for (int q = 0; q < 8; ++q) { const float nr = pr * pr - pi * pi, ni = 2.0f * pr * pi; pr = nr; pi = ni; }
            for (int j = 0; j < ps; ++j) { const float* sl = sloc + ((size_t)(((h * 2 + dir) * 64 + g) * 16 + j) * 64 + pp) * 2;
                const float nr = pr * xr - pi * xi + sl[0], ni = pr * xi + pi * xr + sl[1]; xr = nr; xi = ni; }
            sr[e] = xr; si[e] = xi; }
    }
    const int seqA = (p0 >> 2) & 1, tokA = 4 * (p0 >> 3) + (p0 & 3);
    LAS unsigned* wlu = (LAS unsigned*)wl;
    const int lp0 = segoff + tokA;
    const bf16* arow = ssm + (size_t)(base0 + seqA * seqstride + (dir ? Lq - 1 - lp0 : lp0)) * 1024 + 16 * g + 8 * h;
    const long astep = dir ? -16 * 1024 : 16 * 1024;
    bf16x8 af = *(const bf16x8*)arow, af1 = *(const bf16x8*)(arow + astep);
    for (int st = 0; st < 16; ++st) {
        bf16x8 af2 = af1; if (st < 14) af2 = *(const bf16x8*)(arow + (st + 2) * astep);
        f32x16 D[2][2];
#pragma unroll
        for (int ri = 0; ri < 2; ++ri)
#pragma unroll
            for (int e = 0; e < 2; ++e) { f32x16 z;
#pragma unroll
                for (int q = 0; q < 16; ++q) z[q] = 0.f;
                D[ri][e] = __builtin_amdgcn_mfma_f32_32x32x16_bf16(af, Bf[ri][e], z, 0, 0, 0); }
        asm volatile("" ::: "memory");
#pragma unroll
        for (int tok = 0; tok < 16; ++tok) {
#pragma unroll
            for (int e = 0; e < 2; ++e) { const float nr = lr[e] * sr[e] - li[e] * si[e] + D[0][e][tok], ni = lr[e] * si[e] + li[e] * sr[e] + D[1][e][tok]; sr[e] = nr; si[e] = ni;
                if (kind != 1) wlu[(h * 16 + tok) * 68 + p0 + 32 * e] = pkbf(nr, ni); }
        }
        if (kind != 1) {
            LDS_FENCE();
            const int ci = lane & 15, kq = lane >> 4;
#pragma unroll
            for (int m = 0; m < 2; ++m) { pg8::f32x4 acc = {0.f, 0.f, 0.f, 0.f};
#pragma unroll
                for (int ks = 0; ks < 4; ++ks) { const bf16x8 av = *(const LAS bf16x8*)(wl + (16 * m + ci) * 272 + 64 * ks + 16 * kq);
                    acc = __builtin_amdgcn_mfma_f32_16x16x32_bf16(Cf[ks], av, acc, 0, 0, 0); }
                { const int lp = segoff + 16 * st + ci; const int row = base0 + m * seqstride + (dir ? Lq - 1 - lp : lp);
                    v2u o; o.x = pkbf(acc[0], acc[1]); o.y = pkbf(acc[2], acc[3]);
                    *(v2u*)(ypart + (size_t)row * 1024 + 16 * g + 4 * kq) = o; } }
            LDS_FENCE();
        }
        af = af1; af1 = af2;
    }
#pragma unroll
    for (int e = 0; e < 2; ++e) { const int pp = p0 + 32 * e;
        if (kind == 0) { const int b = 2 * ps + h; const size_t o = (size_t)((b * 2 + dir) * 64 + g) * 64 + pp;
            a.out[(size_t)33554432 + o] = sr[e]; a.out[(size_t)33554432 + 262144 + o] = si[e]; }
        else if (kind == 1) { float* sl = sloc + ((size_t)(((h * 2 + dir) * 64 + g) * 16 + ps) * 64 + pp) * 2; sl[0] = sr[e]; sl[1] = si[e]; } }
}

template <int SET> __device__ __forceinline__ int zidx(int b, int t) { return SET ? b * 4608 + (t >> 6) * 72 + (t & 63) : b * 264 + t; }
template <int SET> struct HyIn { static constexpr int NG = SET ? 2 : 1; v4u q0[3], q1[3]; float hp[3], hn[3], sw0[3], sw1[3], sw2[3], sbv[3]; v4u Rw[2][NG]; v2u Rx[2][NG]; float psum[2], hbias[2]; };
template <int SET> __device__ __forceinline__ void hy_load(KA a, int c, int tid, HyIn<SET>& I) {
    constexpr int L = SET ? 4096 : 256, NG = SET ? 2 : 1, NPB = SET ? 64 : 4;
    const int lane = tid & 63; const int tokbase = SET ? 8192 : 0;
    const bf16* hyT = (const bf16*)(a.ws + WS_HYT);
    const int t0 = tid * 16; const bool first = (t0 % L) == 0, last = ((t0 + 16) % L) == 0;
#pragma unroll
    for (int chn = 0; chn < 3; ++chn) { const int ch = chn * 1024 + c; const bf16* row = hyT + (size_t)ch * 16384 + tokbase + t0;
        I.q0[chn] = *(const v4u*)row; I.q1[chn] = *(const v4u*)(row + 8); I.hp[chn] = first ? 0.f : bf2f(row[-1]); I.hn[chn] = last ? 0.f : bf2f(row[16]);
        I.sw0[chn] = a.in[13][ch]; I.sw1[chn] = a.in[13][3072 + ch]; I.sw2[chn] = a.in[13][6144 + ch]; I.sbv[chn] = a.in[14][ch]; }
#pragma unroll
    for (int o = 0; o < 2; ++o) { const bf16* R = (const bf16*)(a.ws + (SET ? WS_FILT1 : WS_FILT0)) + (size_t)(o * 1024 + c) * (2 * L);
#pragma unroll
        for (int gi = 0; gi < NG; ++gi) { const int m8 = tid + gi * NTHR;
            if (m8 < 2 * L / 8) { I.Rw[o][gi] = *(const v4u*)(R + 8 * m8); I.Rx[o][gi] = *(const v2u*)(R + 8 * m8 + 8); } else { I.Rw[o][gi] = (v4u){0u, 0u, 0u, 0u}; I.Rx[o][gi] = (v2u){0u, 0u}; } }
        const float* part = (const float*)(a.ws + WS_PART) + (SET ? 4 * 4096 : 0); float ps = 0.f;
#pragma unroll
        for (int i0 = 0; i0 < 2 * NPB; i0 += 64) { const int i = i0 + lane; if (i < 2 * NPB) { const int dir = i / NPB, pb = i % NPB; ps += part[pb * 4096 + o * 2048 + dir * 1024 + c]; } }
        I.psum[o] = ps; I.hbias[o] = a.in[23][o * 1024 + c]; }
}
template <int SET> __device__ __forceinline__ void hyena_unit(KA a, LAS unsigned char* lds, int c, int tid, HyIn<SET>& I, bool has_next, int cn) {
    constexpr int L = SET ? 4096 : 256, CPB = (2 * L + 32) * 2  , ZBUF = 18432, NG = SET ? 2 : 1, NPB = SET ? 64 : 4;
    const int lane = tid & 63, wave = __builtin_amdgcn_readfirstlane(tid >> 6);
    const int tokbase = SET ? 8192 : 0;
    const bf16* hyT = (const bf16*)(a.ws + WS_HYT);
    LAS bf16* Z0 = (LAS bf16*)lds; LAS bf16* Z1 = (LAS bf16*)(lds + ZBUF); LAS bf16* X1 = (LAS bf16*)(lds + 2 * ZBUF); LAS bf16* X2 = (LAS bf16*)(lds + 3 * ZBUF);
    LAS unsigned char* cpy = lds + 4 * ZBUF;
    const int t0 = tid * 16; const int zi0 = zidx<SET>(t0 / L, t0 % L);
    const bool first = (t0 % L) == 0, last = ((t0 + 16) % L) == 0;
#pragma unroll
    for (int chn = 0; chn < 3; ++chn) {
        float f[18];
        f[0] = I.hp[chn]; f[17] = I.hn[chn];
        f[1] = pg8::bflo(I.q0[chn].x); f[2] = pg8::bfhi(I.q0[chn].x); f[3] = pg8::bflo(I.q0[chn].y); f[4] = pg8::bfhi(I.q0[chn].y); f[5] = pg8::bflo(I.q0[chn].z); f[6] = pg8::bfhi(I.q0[chn].z); f[7] = pg8::bflo(I.q0[chn].w); f[8] = pg8::bfhi(I.q0[chn].w);
        f[9] = pg8::bflo(I.q1[chn].x); f[10] = pg8::bfhi(I.q1[chn].x); f[11] = pg8::bflo(I.q1[chn].y); f[12] = pg8::bfhi(I.q1[chn].y); f[13] = pg8::bflo(I.q1[chn].z); f[14] = pg8::bfhi(I.q1[chn].z); f[15] = pg8::bflo(I.q1[chn].w); f[16] = pg8::bfhi(I.q1[chn].w);
        float o[16];
#pragma unroll
        for (int i = 0; i < 16; ++i) o[i] = I.sw0[chn] * f[i] + I.sw1[chn] * f[i + 1] + I.sw2[chn] * f[i + 2] + I.sbv[chn];
        const v4u r0 = {pkbf(o[0], o[1]), pkbf(o[2], o[3]), pkbf(o[4], o[5]), pkbf(o[6], o[7])}, r1 = {pkbf(o[8], o[9]), pkbf(o[10], o[11]), pkbf(o[12], o[13]), pkbf(o[14], o[15])};
        LAS bf16* dst = (chn == 0 ? X1 : (chn == 1 ? X2 : Z0)) + zi0;
        *(LAS v4u*)dst = r0; *(LAS v4u*)(dst + 8) = r1;
    }
    const int kh = lane >> 5, n = lane & 31;
    if (tid < 9) *(LAS v4u*)(cpy + 4 * CPB + 16 * tid) = (v4u){0u, 0u, 0u, 0u};
#pragma unroll
    for (int o = 0; o < 2; ++o) {
#pragma unroll
        for (int gi = 0; gi < NG; ++gi) { const int m8 = tid + gi * NTHR;
            if (m8 < 2 * L / 8) { const v4u w = I.Rw[o][gi]; const v2u x = I.Rx[o][gi];
                const v4u c0 = w, c1 = {__builtin_amdgcn_alignbit(w.y, w.x, 16), __builtin_amdgcn_alignbit(w.z, w.y, 16), __builtin_amdgcn_alignbit(w.w, w.z, 16), __builtin_amdgcn_alignbit(x.x, w.w, 16)};
                const v4u c2 = {w.y, w.z, w.w, x.x}, c3 = {__builtin_amdgcn_alignbit(w.z, w.y, 16), __builtin_amdgcn_alignbit(w.w, w.z, 16), __builtin_amdgcn_alignbit(x.x, w.w, 16), __builtin_amdgcn_alignbit(x.y, x.x, 16)};
                *(LAS v4u*)(cpy + 16 * m8) = c0; *(LAS v4u*)(cpy + CPB + 16 * m8) = c1; *(LAS v4u*)(cpy + 2 * CPB + 16 * m8) = c2; *(LAS v4u*)(cpy + 3 * CPB + 16 * m8) = c3; } }
        const float inv = 1.0f / wave_sum(I.psum[o]), bias = I.hbias[o];
        __syncthreads();
        if (o == 1 && has_next) hy_load<SET>(a, cn, tid, I);
        const LAS bf16* Zin = o == 0 ? Z0 : Z1; LAS bf16* Zout = o == 0 ? Z1 : Z0; const LAS bf16* XG = o == 0 ? X1 : X2;
        f32x16 acc, acc2;
#pragma unroll
        for (int q = 0; q < 16; ++q) { acc[q] = 0.f; acc2[q] = 0.f; }
        int idx0;
        if (SET) {
            const int mt = wave & 1, nt = wave >> 1, b = nt >> 1, h1 = nt & 1;
            const int tt0 = 32 * mt + n; const int r = (L - 1 - tt0) & 3;
            const LAS unsigned char* cp = cpy + r * CPB; const int ebase = (L - 1 - tt0 - r) + 8 * kh;
            const int t1 = 32 * h1 + n; const int dlo = h1 ? -31 : -63;
            const LAS bf16* zbase = Zin + b * 4608 + 8 * kh; const LAS bf16* zzero = (const LAS bf16*)(cpy + 4 * CPB) + 8 * kh;
            v4u Aq[4], Bq[4];
            { const LAS unsigned char* ap = cp + 2 * (ebase - 64 * dlo);
                const int s1 = t1 - dlo; const LAS bf16* zp = (unsigned)s1 < 64u ? zbase + 72 * s1 : zzero;
#pragma unroll
                for (int ks = 0; ks < 4; ++ks) { const v2u a0 = *(const volatile LAS v2u*)(ap + 32 * ks), a1 = *(const volatile LAS v2u*)(ap + 32 * ks + 8); Aq[ks] = (v4u){a0.x, a0.y, a1.x, a1.y}; Bq[ks] = *(const LAS v4u*)(zp + 16 * ks); } }
#pragma unroll 5
            for (int di = 0; di < 95; ++di) {
                const int d = dlo + di; const int dn = di < 94 ? d + 1 : d;
                v4u An[4], Bn[4];
                { const LAS unsigned char* ap = cp + 2 * (ebase - 64 * dn);
                    const int s1 = t1 - dn; const LAS bf16* zp = (unsigned)s1 < 64u ? zbase + 72 * s1 : zzero;
#pragma unroll
                    for (int ks = 0; ks < 4; ++ks) { const v2u a0 = *(const volatile LAS v2u*)(ap + 32 * ks), a1 = *(const volatile LAS v2u*)(ap + 32 * ks + 8); An[ks] = (v4u){a0.x, a0.y, a1.x, a1.y}; Bn[ks] = *(const LAS v4u*)(zp + 16 * ks); } }
#pragma unroll
                for (int ks = 0; ks < 4; ++ks) {
                    if (ks & 1) acc2 = __builtin_amdgcn_mfma_f32_32x32x16_bf16(__builtin_bit_cast(bf16x8, Aq[ks]), __builtin_bit_cast(bf16x8, Bq[ks]), acc2, 0, 0, 0);
                    else acc = __builtin_amdgcn_mfma_f32_32x32x16_bf16(__builtin_bit_cast(bf16x8, Aq[ks]), __builtin_bit_cast(bf16x8, Bq[ks]), acc, 0, 0, 0);
                }
#pragma unroll
                for (int ks = 0; ks < 4; ++ks) { Aq[ks] = An[ks]; Bq[ks] = Bn[ks]; }
            }
            idx0 = b * 4608 + 72 * t1 + 32 * mt + 4 * kh;
        } else {
            const int t = 32 * wave + n; const int r = (L - 1 - t) & 3;
            const LAS unsigned char* ap = cpy + r * CPB + 2 * ((L - 1 - t - r) + 8 * kh);
            const LAS bf16* zp = Zin + n * 264 + 8 * kh;
#pragma unroll
            for (int ks = 0; ks < 16; ++ks) {
                const v2u a0 = *(const volatile LAS v2u*)(ap + 32 * ks), a1 = *(const volatile LAS v2u*)(ap + 32 * ks + 8);
                const v4u bv = *(const LAS v4u*)(zp + 16 * ks);
                const v4u av = {a0.x, a0.y, a1.x, a1.y};
                if (ks & 1) acc2 = __builtin_amdgcn_mfma_f32_32x32x16_bf16(__builtin_bit_cast(bf16x8, av), __builtin_bit_cast(bf16x8, bv), acc2, 0, 0, 0);
                else acc = __builtin_amdgcn_mfma_f32_32x32x16_bf16(__builtin_bit_cast(bf16x8, av), __builtin_bit_cast(bf16x8, bv), acc, 0, 0, 0);
            }
            idx0 = n * 264 + 32 * wave + 4 * kh;
        }
#pragma unroll
        for (int reg = 0; reg < 16; ++reg) { const int idx = idx0 + (reg & 3) + 8 * (reg >> 2);
            const float z = bf2f(Zin[idx]), xg = bf2f(XG[idx]);
            Zout[idx] = f2bf(xg * ((acc[reg] + acc2[reg]) * inv + bias * z)); }
        __syncthreads();
    }
    { bf16* row = (bf16*)(a.ws + WS_YHT) + (size_t)c * 16384 + tokbase + t0;
        *(v4u*)row = *(const LAS v4u*)(Z0 + zi0); *(v4u*)(row + 8) = *(const LAS v4u*)(Z0 + zi0 + 8); }
    __syncthreads();
}

__device__ __forceinline__ void combine_items(KA a, int gthr, int nthr) {
    const bf16* ssm = (const bf16*)(a.ws + WS_SSM); const bf16* yf = (const bf16*)(a.ws + WS_A); const bf16* yb = yf + (size_t)16384 * 1024;
    bf16* G = (bf16*)(a.ws + WS_G); const float* dd = a.in[32];
    const bool inv = (nthr & 127) == 0;
    f32x4 d0 = *(const f32x4*)(dd + (gthr & 127) * 8), d1 = *(const f32x4*)(dd + (gthr & 127) * 8 + 4);
#pragma unroll 4
    for (int it = gthr; it < 16384 * 128; it += nthr) { const size_t off = (size_t)it * 8; const int col = (it & 127) * 8;
        const v4u u = *(const v4u*)(ssm + off), f = *(const v4u*)(yf + off), b = *(const v4u*)(yb + off);
        f32x4 u0, u1, f0, f1, b0, b1; pg8::unpack8(u, u0, u1); pg8::unpack8(f, f0, f1); pg8::unpack8(b, b0, b1);
        if (!inv) { d0 = *(const f32x4*)(dd + col); d1 = *(const f32x4*)(dd + col + 4); }
        f32x4 y0 = u0 * d0 + f0 + b0, y1 = u1 * d1 + f1 + b1;
#pragma unroll
        for (int e = 0; e < 4; ++e) { y0[e] = gelu_tanh(y0[e]); y1[e] = gelu_tanh(y1[e]); }
        *(v4u*)(G + off) = pg8::pack8(y0, y1); }
}
__device__ __forceinline__ void yh_transpose_item(KA a, int it, LAS bf16* scr, int lane) {
    const int cb = it & 15, tb = it >> 4;
    const bf16* src = (const bf16*)(a.ws + WS_YHT) + (size_t)(cb * 64) * 16384 + tb * 64;
    bf16* dst = (bf16*)(a.ws + WS_YH) + (size_t)(tb * 64) * 1024 + cb * 64;
#pragma unroll
    for (int i = 0; i < 8; ++i) { const int r = 8 * i + (lane >> 3), ck = lane & 7; const v4u v = *(const v4u*)(src + (size_t)r * 16384 + 8 * ck);
        LAS unsigned* s = (LAS unsigned*)(scr + r * 66 + 8 * ck); s[0] = v.x; s[1] = v.y; s[2] = v.z; s[3] = v.w; }
    LDS_FENCE();
#pragma unroll
    for (int i = 0; i < 8; ++i) { const int t = 8 * i + (lane >> 3), ck = lane & 7;
        unsigned short e[8];
#pragma unroll
        for (int j = 0; j < 8; ++j) e[j] = scr[(8 * ck + j) * 66 + t];
        const v4u o = {(unsigned)e[0] | ((unsigned)e[1] << 16), (unsigned)e[2] | ((unsigned)e[3] << 16), (unsigned)e[4] | ((unsigned)e[5] << 16), (unsigned)e[6] | ((unsigned)e[7] << 16)};
        *(v4u*)(dst + (size_t)t * 1024 + 8 * ck) = o; }
    LDS_FENCE();
}

template <int NX> __device__ __forceinline__ void conv_strip(const bf16* up, bf16* act, const float* cw, const float* cbias, int CN, int ca0,
        int tok0, int mstride, int S, int s0, int ns, bool xl, bool xr, int j0) {
    const int ld = 2 * CN;
    f32x4 wa[3][NX], wb[3][NX];
#pragma unroll
    for (int m = 0; m < 3; ++m)
#pragma unroll
        for (int x = 0; x < NX; ++x) { const int tap = NX == 3 ? m * 3 + x : 3 + m; wa[m][x] = *(const f32x4*)(cw + tap * 11264 + ca0 + j0); wb[m][x] = *(const f32x4*)(cw + tap * 11264 + 5632 + ca0 + j0); }
    const f32x4 ba = *(const f32x4*)(cbias + ca0 + j0), bb = *(const f32x4*)(cbias + 5632 + ca0 + j0);
    v2u ring[8][NX][2];
    const int slast = s0 + ns;
#define CONV_LOAD(dst, sidx) do { const int s_ = (sidx); const bool vs_ = s_ >= 0 && s_ < S && s_ <= slast; \
        _Pragma("unroll") for (int x = 0; x < NX; ++x) { const bool v_ = vs_ && (NX == 1 || (x == 0 ? xl : (x == 2 ? xr : true))); \
            if (v_) { const bf16* q_ = up + (size_t)(tok0 + s_ * mstride + (NX == 3 ? x - 1 : 0)) * ld + j0; dst[x][0] = *(const v2u*)q_; dst[x][1] = *(const v2u*)(q_ + CN); } \
            else { dst[x][0] = (v2u){0u, 0u}; dst[x][1] = (v2u){0u, 0u}; } } } while (0)
#pragma unroll
    for (int k = 0; k < 7; ++k) CONV_LOAD(ring[k], s0 - 1 + k);
    for (int sb = s0; sb < slast; sb += 8) {
#pragma unroll
        for (int j = 0; j < 8; ++j) { const int s = sb + j;
            CONV_LOAD(ring[(j + 7) & 7], s + 6);
            f32x4 sa = ba, sb2 = bb;
#pragma unroll
            for (int m = 0; m < 3; ++m)
#pragma unroll
                for (int x = 0; x < NX; ++x) { const v2u pa = ring[(j + m) & 7][x][0], pb = ring[(j + m) & 7][x][1];
                    const f32x4 va = {pg8::bflo(pa.x), pg8::bfhi(pa.x), pg8::bflo(pa.y), pg8::bfhi(pa.y)}, vb = {pg8::bflo(pb.x), pg8::bfhi(pb.x), pg8::bflo(pb.y), pg8::bfhi(pb.y)};
                    sa += va * wa[m][x]; sb2 += vb * wb[m][x]; }
            v2u o; o.x = pkbf(gelu_tanh(sa.x) * sb2.x, gelu_tanh(sa.y) * sb2.y); o.y = pkbf(gelu_tanh(sa.z) * sb2.z, gelu_tanh(sa.w) * sb2.w);
            *(v2u*)(act + (size_t)(tok0 + s * mstride) * CN + j0) = o; }
    }
#undef CONV_LOAD
}
__device__ __forceinline__ void conv_items(KA a, int gw, int NGW, int lane, int CN, int ca0) {
    const bf16* up = (const bf16*)(a.ws + WS_UP); bf16* act = (bf16*)(a.ws + WS_ACT);
    const float* cw = a.in[38]; const float* cbias = a.in[39];
    const int nslab = CN >> 8; const int nlat = 512 * nslab, ntot = 768 * nslab;
    for (int it = gw; it < ntot; it += NGW) {
        if (it < nlat) { const int gq = it & 63, b = (it >> 6) & 1, t = it >> 7; const int seg = t & 3, slab = t >> 2;
            conv_strip<3>(up, act, cw, cbias, CN, ca0, 8192 + b * 4096 + gq, 64, 64, seg * 16, 16, gq > 0, gq < 63, slab * 256 + 4 * lane); }
        else { const int r = it - nlat; const int slab = r % nslab, t = r / nslab; const int seg = t & 7, sq = t >> 3;
            conv_strip<1>(up, act, cw, cbias, CN, ca0, sq * 256, 1, 256, seg * 32, 32, false, false, slab * 256 + 4 * lane); }
    }
}

#define XB_TMO      128
#define XB_XCNT(j)  (256  + 64 * (j))
#define XB_XSUB(j)  (1280 + 64 * (j))
#define XB_XGEN(j)  (2304 + 64 * (j))
#define XB_TOP      3328
#define XB_TOPGEN   3392
#define XCD_BAR_WORDS 3456
#define XB_SPIN_CAP (1u << 18)

__device__ __forceinline__ unsigned xb_ld(unsigned* p)              { return __hip_atomic_load(p, __ATOMIC_RELAXED, __HIP_MEMORY_SCOPE_AGENT); }
__device__ __forceinline__ unsigned xb_add(unsigned* p, unsigned v) { return __hip_atomic_fetch_add(p, v, __ATOMIC_RELAXED, __HIP_MEMORY_SCOPE_AGENT); }
__device__ __forceinline__ unsigned xb_xcc_id() { return (unsigned)__builtin_amdgcn_s_getreg((3 << 11) | 20) & 0xFu; }
#define XB_SPIN(cond, bar) do { unsigned _sp = 0; while (cond) { __builtin_amdgcn_s_sleep(1); \
    if ((++_sp & 255u) == 0u) { if (xb_ld(&(bar)[XB_TMO])) break; if (_sp > XB_SPIN_CAP) { atomicAdd(&(bar)[XB_TMO], 1u); break; } } } } while (0)

struct XcdBarrier {
    unsigned* bar; unsigned x;
    volatile LAS unsigned* st;
};

__device__ __forceinline__ XcdBarrier xcd_barrier_post(unsigned* bar, volatile LAS unsigned* st) {
    XcdBarrier b; b.bar = bar; b.x = xb_xcc_id(); b.st = st;
    if (threadIdx.x == 0) (void)xb_add(&bar[XB_XCNT(b.x)], 1u);
    return b;
}
__device__ __forceinline__ void xcd_barrier_complete(unsigned* bar, unsigned x, unsigned& nloc, unsigned& nx) {
    const unsigned G = gridDim.x * gridDim.y * gridDim.z;
    unsigned sum, cnt, mine, sp = 0u;
    for (;;) {
        sum = 0u; cnt = 0u; mine = 0u;
#pragma unroll
        for (unsigned j = 0; j < 16; ++j) { const unsigned c = xb_ld(&bar[XB_XCNT(j)]); sum += c; cnt += (c > 0u) ? 1u : 0u; mine = (j == x) ? c : mine; }
        if (sum == G) break;
        __builtin_amdgcn_s_sleep(1);
        if ((++sp & 255u) == 0u) { if (xb_ld(&bar[XB_TMO])) break; if (sp > XB_SPIN_CAP) { atomicAdd(&bar[XB_TMO], 1u); break; } }
    }
    nloc = mine > 0u ? mine : 1u; nx = cnt > 0u ? cnt : 1u;
}

__device__ __forceinline__ void xcd_barrier(const XcdBarrier& b) {
    asm volatile("s_waitcnt vmcnt(0)" ::: "memory");
    __syncthreads();
    if (threadIdx.x == 0) {
        unsigned* bar = b.bar;
        __builtin_amdgcn_s_waitcnt(0);
        unsigned nloc = b.st[0], nx = b.st[1];
        if (nloc == 0u) { xcd_barrier_complete(bar, b.x, nloc, nx); b.st[0] = nloc; b.st[1] = nx; }
        const unsigned old = xb_add(&bar[XB_XSUB(b.x)], 1u);
        const unsigned gen = old / nloc;
        if (old + 1u == (gen + 1u) * nloc) {
            __builtin_amdgcn_fence(__ATOMIC_RELEASE, "agent");
            asm volatile("s_waitcnt vmcnt(0)" ::: "memory");
            const unsigned og = xb_add(&bar[XB_TOP], 1u);
            const unsigned tg = og / nx;
            if (og + 1u == (tg + 1u) * nx) xb_add(&bar[XB_TOPGEN], 1u);
            else XB_SPIN(xb_ld(&bar[XB_TOPGEN]) == tg, bar);
            __builtin_amdgcn_fence(__ATOMIC_ACQUIRE, "agent");
            xb_add(&bar[XB_XGEN(b.x)], 1u);
            asm volatile("s_waitcnt vmcnt(0)" ::: "memory");
        } else {
            XB_SPIN(xb_ld(&bar[XB_XGEN(b.x)]) == gen, bar);
            __builtin_amdgcn_fence(__ATOMIC_ACQUIRE, "agent");
            asm volatile("s_waitcnt vmcnt(0)" ::: "memory");
        }
    }
    __syncthreads();
}


struct TrItem { const float* src; int N; bf16* dst; int ldk; };
__device__ __forceinline__ void tr_load(const TrItem& t, f32x4 (&v)[16], int lane) {
    const int rs = lane >> 4, c4 = lane & 15;
#pragma unroll
    for (int i = 0; i < 16; ++i) v[i] = *(const f32x4*)(t.src + (size_t)(4 * i + rs) * t.N + 4 * c4);
}
__device__ __forceinline__ void tr_lds_write(const f32x4 (&v)[16], LAS float* scr, int lane) {
    const int rs = lane >> 4, c4 = lane & 15;
#pragma unroll
    for (int i = 0; i < 16; ++i) { LAS float* d = scr + (4 * i + rs) * 65 + 4 * c4; d[0] = v[i].x; d[1] = v[i].y; d[2] = v[i].z; d[3] = v[i].w; }
}
__device__ __forceinline__ void tr_store(const TrItem& t, const LAS float* scr, int lane) {
    const int c = lane & 7, ns = lane >> 3;
#pragma unroll
    for (int j = 0; j < 8; ++j) { const int n = ns + 8 * j; const LAS float* q = scr + (8 * c) * 65 + n;
        v4u o; o.x = pkbf(q[0 * 65], q[1 * 65]); o.y = pkbf(q[2 * 65], q[3 * 65]); o.z = pkbf(q[4 * 65], q[5 * 65]); o.w = pkbf(q[6 * 65], q[7 * 65]);
        *(v4u*)(t.dst + (size_t)n * t.ldk + 8 * c) = o; }
}
__device__ __forceinline__ TrItem p0_item(KA a, unsigned char* ws, int r) {
    const float* W; int N, ldk, n0, k0; bf16* WT;
    if (r < 4096) { W = a.in[11]; N = 8192; WT = (bf16*)(ws + WS_WIN); ldk = 2048; n0 = (r & 127) * 64; k0 = (r >> 7) * 64; }
    else if ((r -= 4096) < 256) { W = a.in[33]; N = 1024; WT = (bf16*)(ws + WS_WGLU); ldk = 1024; n0 = (r & 15) * 64; k0 = (r >> 4) * 64; }
    else if ((r -= 256) < 512) { W = a.in[24]; N = 2048; WT = (bf16*)(ws + WS_WBH); ldk = 1024; n0 = (r & 31) * 64; k0 = (r >> 5) * 64; }
    else if ((r -= 512) < 512) { W = a.in[35]; N = 2048; WT = (bf16*)(ws + WS_WBS); ldk = 1024; n0 = (r & 31) * 64; k0 = (r >> 5) * 64; }
    else { r -= 512; W = a.in[36]; N = 2048; WT = (bf16*)(ws + WS_WOUT); ldk = 2048; n0 = (r & 31) * 64; k0 = (r >> 5) * 64; }
    TrItem t; t.src = W + (size_t)k0 * N + n0; t.N = N; t.dst = WT + (size_t)n0 * ldk + k0; t.ldk = ldk; return t;
}
__device__ __forceinline__ TrItem p9_item(KA a, unsigned char* ws, int it) {
    TrItem t;
    if (it < 5632) { const int nb = it % 176, kb = it / 176; const int n0 = nb * 64;
        int drow; if (n0 < 5632) drow = n0 < CA0 ? n0 : 2 * CA0 + (n0 - CA0); else { const int m = n0 - 5632; drow = m < CA0 ? CA0 + m : 2 * CA0 + CA1 + (m - CA0); }
        t.src = a.in[37] + (size_t)(kb * 64) * 11264 + n0; t.N = 11264; t.dst = (bf16*)(ws + WS_WUP) + (size_t)drow * 2048 + kb * 64; t.ldk = 2048; }
    else { const int r = it - 5632; const int nb = r & 31, kb = r >> 5; const int k0 = kb * 64;
        t.src = a.in[40] + (size_t)k0 * 2048 + nb * 64; t.N = 2048;
        if (k0 < CA0) { t.dst = (bf16*)(ws + WS_WD0) + (size_t)(nb * 64) * CA0 + k0; t.ldk = CA0; } else { t.dst = (bf16*)(ws + WS_WD1) + (size_t)(nb * 64) * CA1 + (k0 - CA0); t.ldk = CA1; } }
    return t;
}
#define TR_PIPELINE(ITEMFN, NITEMS) do { int it_ = gw; if (it_ < (NITEMS)) { TrItem cur_ = ITEMFN(a, ws, it_); f32x4 v_[16]; tr_load(cur_, v_, lane); \
        for (;;) { tr_lds_write(v_, scr, lane); LDS_FENCE(); const int nx_ = it_ + NGW; const bool hn_ = nx_ < (NITEMS); TrItem nxt_ = cur_; \
            if (hn_) { nxt_ = ITEMFN(a, ws, nx_); tr_load(nxt_, v_, lane); } asm volatile("" ::: "memory"); \
            tr_store(cur_, scr, lane); LDS_FENCE(); if (!hn_) break; cur_ = nxt_; it_ = nx_; } } } while (0)

__global__ void __launch_bounds__(NTHR, 2) fwd_kernel(Args a_) {
    extern __shared__ __attribute__((aligned(16))) unsigned char lds_raw[];
    LAS unsigned char* lds = (LAS unsigned char*)lds_raw;
    const int tid = threadIdx.x, lane = tid & 63, wave = __builtin_amdgcn_readfirstlane(tid >> 6);
    const int G = gridDim.x, bid = blockIdx.x;
    const int gw = bid * NWAVES + wave, NGW = G * NWAVES;
    const int gthr = bid * NTHR + tid, nthr = G * NTHR;
    cg::grid_group grid = cg::this_grid();
    unsigned* barw = (unsigned*)(a_.ws + WS_BAR);
    volatile LAS unsigned* bst = (volatile LAS unsigned*)(lds + LDS_BYTES - 16);
    if (tid < 2) bst[tid] = 0u;
    __syncthreads();
    XcdBarrier xbar = xcd_barrier_post(barw, bst);
    if (a_.ph_lo < 0) grid.sync();
    const int lo = a_.ph_lo, hi = a_.ph_hi;
#define PHASE_ARGS KA a = *kargs(); unsigned char* ws = a.ws; const float* mod = (const float*)(ws + WS_MOD); (void)mod
#ifndef REP_FILT
#define REP_FILT 0
#endif
#ifndef REP_S5
#define REP_S5 0
#endif
#ifndef REP_HY0
#define REP_HY0 0
#endif
#ifndef REP_HY1
#define REP_HY1 0
#endif
#ifndef REP_MASK
#define REP_MASK 0
#endif
#define REPN(k) (((REP_MASK) >> (k)) & 1)
#ifndef PH_MASK
#define PH_MASK 0xffff
#endif
#define IN(k) ((((PH_MASK) >> (k)) & 1) && lo <= (k) && (k) < hi)
#define SEAM(k) do { if (IN(k) && IN((k) + 1)) xcd_barrier(xbar); } while (0)

    if (IN(0)) for (int rep_ = 0; rep_ <= REPN(0); ++rep_) { if (rep_) __syncthreads(); PHASE_ARGS;
        constexpr int N_H3 = 272, N_T = 6400;
        for (int u = bid; u < 192; u += G) mod_block_unit(a, lds, u, tid);
        LAS float* scr = (LAS float*)(lds + wave * 16640);
        if (gw >= NGW - N_H3) h3_unit(a, NGW - 1 - gw, lane);
        TR_PIPELINE(p0_item, N_T);
    }
    SEAM(0);
#ifdef EXTRA_SYNCS
    for (int q_ = 0; q_ < EXTRA_SYNCS; ++q_) grid.sync();
#endif
    if (IN(1)) for (int rep_ = 0; rep_ <= REPN(1); ++rep_) { if (rep_) __syncthreads(); PHASE_ARGS;
        for (int rf_ = 0; rf_ <= REP_FILT; ++rf_)
        for (int it = gw; it < 4352; it += NGW) filt_unit(a, it, lane);
        norm_rows<0, false>(a.in[0], a.in[1], a.in[8], mod + 2048, mod, (bf16*)(ws + WS_A), gw, NGW, lane);
    }
    SEAM(1);
    if (IN(2)) for (int rep_ = 0; rep_ <= REPN(2); ++rep_) { if (rep_) __syncthreads(); PHASE_ARGS;
        { pg8::Gemm g{(const bf16*)(ws + WS_WIN), (const bf16*)(ws + WS_A), 3072, 16384, 2048}; pg8::StaticOrder S; S.init(3072, 16384, G, bid);
          pg8::EpiHyT E{(bf16*)(ws + WS_HYT), a.in[12]};
          pg8::gemm_phase<pg8::EpiHyT, pg8::StaticOrder, true, true>(lds, g, S, E); }
        { pg8::Gemm g{(const bf16*)(ws + WS_A), (const bf16*)(ws + WS_WIN) + (size_t)3072 * 2048, 16384, 5120, 2048}; pg8::StaticOrder S; S.init(16384, 5120, G, bid);
          pg8::EpiRest E{(bf16*)(ws + WS_SSM), (bf16*)(ws + WS_GATES), a.in[12] + 3072};
          pg8::gemm_phase<pg8::EpiRest, pg8::StaticOrder, true, true>(lds, g, S, E); }
    }
    SEAM(2);
    if (IN(3)) for (int rep_ = 0; rep_ <= REPN(3); ++rep_) { if (rep_) __syncthreads(); PHASE_ARGS;
        for (int rs_ = 0; rs_ <= REP_S5; ++rs_)
        for (int it = gw; it < 4096; it += NGW) { const int kind = it < 2048 ? 0 : 1; const int r = it & 2047; const int g = r & 63, dir = (r >> 6) & 1, ps = r >> 7;
            if (kind == 1 && ps == 15) continue;
            if (kind == 0) s5_unit(a, lds + wave * 8704, 0, ps, dir, g, lane); else s5_unit(a, lds + wave * 8704, 1, ps, dir, g, lane); }
        __syncthreads();
        for (int rh_ = 0; rh_ <= REP_HY0; ++rh_)
        { HyIn<0> I; if (bid < 1024) hy_load<0>(a, bid, tid, I);
          for (int c = bid; c < 1024; c += G) hyena_unit<0>(a, lds, c, tid, I, c + G < 1024, c + G); }
    }
    SEAM(3);
    if (IN(4)) for (int rep_ = 0; rep_ <= REPN(4); ++rep_) { if (rep_) __syncthreads(); PHASE_ARGS;
        for (int rs_ = 0; rs_ <= REP_S5; ++rs_)
        for (int it = gw; it < 2048; it += NGW) { const int g = it & 63, dir = (it >> 6) & 1, ps = it >> 7; s5_unit(a, lds + wave * 8704, 2, ps, dir, g, lane); }
        __syncthreads();
        for (int rh_ = 0; rh_ <= REP_HY1; ++rh_)
        { HyIn<1> I; if (bid < 1024) hy_load<1>(a, bid, tid, I);
          for (int c = bid; c < 1024; c += G) hyena_unit<1>(a, lds, c, tid, I, c + G < 1024, c + G); }
    }
    SEAM(4);
    if (IN(5)) for (int rep_ = 0; rep_ <= REPN(5); ++rep_) { if (rep_) __syncthreads(); PHASE_ARGS;
        combine_items(a, gthr, nthr);
        for (int it = gw; it < 4096; it += NGW) yh_transpose_item(a, it, (LAS bf16*)(lds + wave * 8448), lane);
    }
    SEAM(5);
    if (IN(6)) for (int rep_ = 0; rep_ <= REPN(6); ++rep_) { if (rep_) __syncthreads(); PHASE_ARGS;
        pg8::Gemm g{(const bf16*)(ws + WS_G), (const bf16*)(ws + WS_WGLU), 16384, 1024, 1024}; pg8::StaticOrder S; S.init(16384, 1024, G, bid);
        pg8::EpiGate<0> E{(bf16*)(ws + WS_YS), 1024, (const bf16*)(ws + WS_G), 1024, a.in[34]};
        pg8::gemm_phase<pg8::EpiGate<0>, pg8::StaticOrder, true, true>(lds, g, S, E);
    }
    SEAM(6);
    if (IN(7)) for (int rep_ = 0; rep_ <= REPN(7); ++rep_) { if (rep_) __syncthreads(); PHASE_ARGS;
        { pg8::Gemm g{(const bf16*)(ws + WS_YH), (const bf16*)(ws + WS_WBH), 16384, 2048, 1024}; pg8::StaticOrder S; S.init(16384, 2048, G, bid);
          pg8::EpiBr<1> E{(bf16*)(ws + WS_MERGED), (const unsigned char*)(ws + WS_GATES), 0};
          pg8::gemm_phase<pg8::EpiBr<1>, pg8::StaticOrder, true, true>(lds, g, S, E); }
        { pg8::Gemm g{(const bf16*)(ws + WS_YS), (const bf16*)(ws + WS_WBS), 16384, 2048, 1024}; pg8::StaticOrder S; S.init(16384, 2048, G, bid);
          pg8::EpiBr<2> E{(bf16*)(ws + WS_MERGED), (const unsigned char*)(ws + WS_GATES), 2048};
          pg8::gemm_phase<pg8::EpiBr<2>, pg8::StaticOrder, true, true>(lds, g, S, E); }
    }
    SEAM(7);
    if (IN(8)) for (int rep_ = 0; rep_ <= REPN(8); ++rep_) { if (rep_) __syncthreads(); PHASE_ARGS;
        pg8::Gemm g{(const bf16*)(ws + WS_MERGED), (const bf16*)(ws + WS_WOUT), 16384, 2048, 2048}; pg8::StaticOrder S; S.init(16384, 2048, G, bid);
        pg8::EpiRes E{a.in[0], a.in[1], a.out, mod + 2 * 2048};
        pg8::gemm_phase<pg8::EpiRes, pg8::StaticOrder, true, true>(lds, g, S, E);
    }
    SEAM(8);
    if (IN(9)) for (int rep_ = 0; rep_ <= REPN(9); ++rep_) { if (rep_) __syncthreads(); PHASE_ARGS;
        LAS float* scr = (LAS float*)(lds + wave * 16640);
        norm_rows<0, true>(a.out, nullptr, a.in[9], mod + 4 * 2048, mod + 3 * 2048, (bf16*)(ws + WS_A), gw, NGW, lane);
        TR_PIPELINE(p9_item, 5632 + 2816);
    }
    SEAM(9);
    if (IN(10)) for (int rep_ = 0; rep_ <= REPN(10); ++rep_) { if (rep_) __syncthreads(); PHASE_ARGS;
        pg8::Gemm g{(const bf16*)(ws + WS_A), (const bf16*)(ws + WS_WUP), 16384, 2 * CA0, 2048}; pg8::StaticOrder S; S.init(16384, 2 * CA0, G, bid);
        pg8::EpiPlain E{(bf16*)(ws + WS_UP), 2 * CA0};
        pg8::gemm_phase<pg8::EpiPlain, pg8::StaticOrder, true, true>(lds, g, S, E);
    }
    SEAM(10);
    if (IN(11)) for (int rep_ = 0; rep_ <= REPN(11); ++rep_) { if (rep_) __syncthreads(); PHASE_ARGS; (void)ws; conv_items(a, gw, NGW, lane, CA0, 0); }
    SEAM(11);
    if (IN(12)) for (int rep_ = 0; rep_ <= REPN(12); ++rep_) { if (rep_) __syncthreads(); PHASE_ARGS;
        { pg8::Gemm g{(const bf16*)(ws + WS_ACT), (const bf16*)(ws + WS_WD0), 16384, 2048, CA0}; pg8::StaticOrder S; S.init(16384, 2048, G, bid);
          pg8::EpiRes E{nullptr, nullptr, a.out, mod + 5 * 2048};
          pg8::gemm_phase<pg8::EpiRes, pg8::StaticOrder, true, true>(lds, g, S, E); }
        { pg8::Gemm g{(const bf16*)(ws + WS_A), (const bf16*)(ws + WS_WUP) + (size_t)2 * CA0 * 2048, 16384, 2 * CA1, 2048}; pg8::StaticOrder S; S.init(16384, 2 * CA1, G, bid);
          pg8::EpiPlain E{(bf16*)(ws + WS_UP), 2 * CA1};
          pg8::gemm_phase<pg8::EpiPlain, pg8::StaticOrder, true, true>(lds, g, S, E); }
    }
    SEAM(12);
    if (IN(13)) for (int rep_ = 0; rep_ <= REPN(13); ++rep_) { if (rep_) __syncthreads(); PHASE_ARGS; (void)ws; conv_items(a, gw, NGW, lane, CA1, CA0); }
    SEAM(13);
    if (IN(14)) for (int rep_ = 0; rep_ <= REPN(14); ++rep_) { if (rep_) __syncthreads(); PHASE_ARGS;
        pg8::Gemm g{(const bf16*)(ws + WS_ACT), (const bf16*)(ws + WS_WD1), 16384, 2048, CA1}; pg8::StaticOrder S; S.init(16384, 2048, G, bid);
        pg8::EpiRes E{nullptr, nullptr, a.out, mod + 5 * 2048};
        pg8::gemm_phase<pg8::EpiRes, pg8::StaticOrder, true, true>(lds, g, S, E);
    }
    SEAM(14);
    if (IN(15)) for (int rep_ = 0; rep_ <= REPN(15); ++rep_) { if (rep_) __syncthreads(); PHASE_ARGS;
        norm_rows<1, true>(a.out, nullptr, a.in[10], nullptr, nullptr, a.out, gw, NGW, lane);
    }
#undef IN
#undef SEAM
}

#ifndef MK_SINGLE
#define MK_SINGLE 1
#endif
constexpr int N_PHASES = 16;
extern "C" void kernel_launch(void* const* d_in, const int* in_sizes, int n_in, void* d_out, int out_size, void* d_ws, size_t ws_size, hipStream_t stream) {
    static int grid = 0;
    if (grid == 0) {
        if (n_in != 41 || ws_size < WS_END) { fprintf(stderr, "kernel_launch: need 41 inputs and %zu bytes of workspace (got %d, %zu)\n", (size_t)WS_END, n_in, ws_size); grid = -1; return; }
        int dev = 0, cus = 0, per_cu = 0;
        if (hipGetDevice(&dev) != hipSuccess || hipDeviceGetAttribute(&cus, hipDeviceAttributeMultiprocessorCount, dev) != hipSuccess) { grid = -1; return; }
        if (hipFuncSetAttribute((const void*)fwd_kernel, hipFuncAttributeMaxDynamicSharedMemorySize, LDS_BYTES) != hipSuccess) { fprintf(stderr, "kernel_launch: hipFuncSetAttribute failed\n"); grid = -1; return; }
        if (hipOccupancyMaxActiveBlocksPerMultiprocessor(&per_cu, (const void*)fwd_kernel, NTHR, LDS_BYTES) != hipSuccess || per_cu < 1) { fprintf(stderr, "kernel_launch: occupancy query gave %d\n", per_cu); per_cu = 1; }
        (void)hipGetLastError();
        grid = cus * (per_cu < 1 ? 1 : 1);
    }
    if (grid < 0) return;
    (void)hipMemsetAsync((char*)d_ws + WS_BAR, 0, 16384, stream);
    Args a{};
    for (int i = 0; i < 41; ++i) a.in[i] = (const float*)d_in[i];
    a.out = (float*)d_out; a.ws = (unsigned char*)d_ws;
#if MK_SINGLE
    a.ph_lo = 0; a.ph_hi = N_PHASES;
    void* args[] = {&a};
    hipError_t e = hipLaunchCooperativeKernel((const void*)fwd_kernel, dim3(grid), dim3(NTHR), args, LDS_BYTES, stream);
    if (e != hipSuccess) fprintf(stderr, "kernel_launch: cooperative launch failed: %s (grid %d)\n", hipGetErrorString(e), grid);
#else
#ifndef DBG_STOP
#define DBG_STOP N_PHASES
#endif
    for (int ph = 0; ph < DBG_STOP; ++ph) { a.ph_lo = ph; a.ph_hi = ph + 1;
        hipLaunchKernelGGL(fwd_kernel, dim3(grid), dim3(NTHR), LDS_BYTES, stream, a); }
#endif
}
```
